# Optimizing an MI355X kernel written in HIP

```python
import jax, jax.numpy as jnp
from jax import lax
import numpy as np

D_MODEL = 1024
BATCH = 4
SEQ = 8192
DEPTH = 1

MIX_WIDTH = D_MODEL
POOL_WIDTH = D_MODEL // 4
POOL_WINDOWS = (2, 4, 8, 16)
POOL_GROUP = POOL_WIDTH // len(POOL_WINDOWS)
HEAD_DIM = 64
ATTN_WIDTH = MIX_WIDTH - POOL_WIDTH
N_HEADS = ATTN_WIDTH // HEAD_DIM
DILATED_CONFIGS = ((128, 1), (512, 4), (2048, 16))
BLOCK = 128
ROPE_THETA = 10000.0
IN_WIDTH = POOL_WIDTH + 3 * ATTN_WIDTH
_FF_RAW = -(-8 * D_MODEL // 3)
D_FF = ((_FF_RAW + 255) // 256) * 256
EPS = 1e-6

kernel_name = "hybrid_pool_dilated_attn_block"


def rms_norm(x, g):
    xf = x.astype(jnp.float32)
    y = xf * lax.rsqrt(jnp.mean(xf * xf, axis=-1, keepdims=True) + EPS)
    return (y * g.astype(jnp.float32)).astype(x.dtype)


def rope(x, pos):
    half = x.shape[-1] // 2
    freqs = ROPE_THETA ** (-jnp.arange(half, dtype=jnp.float32) * (2.0 / x.shape[-1]))
    ang = pos.astype(jnp.float32)[:, None] * freqs[None, :]
    cos = jnp.cos(ang)[None, :, None, :]
    sin = jnp.sin(ang)[None, :, None, :]
    xf = x.astype(jnp.float32)
    x1, x2 = xf[..., :half], xf[..., half:]
    out = jnp.concatenate([x1 * cos - x2 * sin, x2 * cos + x1 * sin], axis=-1)
    return out.astype(x.dtype)


def multi_scale_pool(u, w_pool, pool_scale):
    B, S, _ = u.shape
    ug = u.astype(jnp.float32).reshape(B, S, len(POOL_WINDOWS), POOL_GROUP)
    csum = lax.cumsum(ug, axis=1)
    t = jnp.arange(S)
    outs = []
    for gi, win in enumerate(POOL_WINDOWS):
        cg = csum[:, :, gi]
        shifted = jnp.pad(cg, ((0, 0), (win, 0), (0, 0)))[:, :S]
        cnt = jnp.minimum(t + 1, win).astype(jnp.float32)[None, :, None]
        outs.append((cg - shifted) / cnt - ug[:, :, gi])
    d = jnp.stack(outs, axis=2)
    y = jnp.einsum('bsgc,gcd->bsgd', d, w_pool.astype(jnp.float32))
    y = y.reshape(B, S, POOL_WIDTH) * pool_scale.astype(jnp.float32)
    return y.astype(u.dtype)


def dilated_branch(q, k, v, window, dilation):
    B, S, H, Dh = q.shape
    L = S // dilation
    nb = -(-L // BLOCK)
    Lp = nb * BLOCK
    w_sub = window // dilation

    def to_sub(a):
        a = a.reshape(B, L, dilation, H, Dh).transpose(0, 2, 1, 3, 4)
        return jnp.pad(a, ((0, 0), (0, 0), (0, Lp - L), (0, 0), (0, 0)))

    qs = to_sub(q).reshape(B, dilation, nb, BLOCK, H, Dh)
    kp = jnp.pad(to_sub(k), ((0, 0), (0, 0), (BLOCK, 0), (0, 0), (0, 0)))
    vp = jnp.pad(to_sub(v), ((0, 0), (0, 0), (BLOCK, 0), (0, 0), (0, 0)))

    def band(a):
        prev = a[:, :, :Lp].reshape(B, dilation, nb, BLOCK, H, Dh)
        cur = a[:, :, BLOCK:].reshape(B, dilation, nb, BLOCK, H, Dh)
        return jnp.concatenate([prev, cur], axis=3)

    kb, vb = band(kp), band(vp)
    scale = 1.0 / np.sqrt(Dh).astype(np.float32)
    s = jnp.einsum('brnqhd,brnkhd->brnhqk', qs.astype(jnp.float32), kb.astype(jnp.float32)) * scale

    qi = jnp.arange(BLOCK)[:, None]
    kj = jnp.arange(2 * BLOCK)[None, :]
    dist = qi + BLOCK - kj
    blk = jnp.arange(nb)[:, None, None]
    valid = (dist >= 0) & (dist <= w_sub) & (blk * BLOCK + kj - BLOCK >= 0)
    s = jnp.where(valid[None, None, :, None], s, -jnp.inf)

    m = jnp.max(s, axis=-1, keepdims=True)
    e = jnp.exp(s - m)
    den = jnp.sum(e, axis=-1, keepdims=True)
    lse = (m + jnp.log(den))[..., 0]
    o = jnp.einsum('brnhqk,brnkhd->brnqhd', e / den, vb.astype(jnp.float32))

    o = o.reshape(B, dilation, Lp, H, Dh)[:, :, :L].transpose(0, 2, 1, 3, 4).reshape(B, S, H, Dh)
    lse = lse.transpose(0, 1, 2, 4, 3).reshape(B, dilation, Lp, H)[:, :, :L]
    lse = lse.transpose(0, 2, 1, 3).reshape(B, S, H)
    return o, lse


def dilated_attention(q, k, v):
    outs, lses = [], []
    for window, dilation in DILATED_CONFIGS:
        o, lse = dilated_branch(q, k, v, window, dilation)
        outs.append(o)
        lses.append(lse)
    w = jax.nn.softmax(jnp.stack(lses, axis=0), axis=0)
    o = jnp.sum(w[..., None] * jnp.stack(outs, axis=0), axis=0)
    return o.astype(q.dtype)


def setup_inputs(seed: int = 0) -> dict:
    key = jax.random.key(seed)
    ks = jax.random.split(key, 13)
    f32 = jnp.float32
    nrm = lambda k, shape, s: jax.random.normal(k, shape, f32) * s
    return {
        "x": jax.random.normal(ks[0], (BATCH, SEQ, D_MODEL), f32),
        "ln_pre_mix": 1.0 + nrm(ks[1], (DEPTH, D_MODEL), 0.05),
        "w_in": nrm(ks[2], (DEPTH, D_MODEL, IN_WIDTH), D_MODEL ** -0.5),
        "w_pool": nrm(ks[3], (DEPTH, len(POOL_WINDOWS), POOL_GROUP, POOL_GROUP), POOL_GROUP ** -0.5),
        "pool_scale": 1.0 + nrm(ks[4], (DEPTH, POOL_WIDTH), 0.1),
        "w_out": nrm(ks[5], (DEPTH, MIX_WIDTH, D_MODEL), MIX_WIDTH ** -0.5),
        "ln_post_mix": 1.0 + nrm(ks[6], (DEPTH, D_MODEL), 0.05),
        "ln_pre_ffn": 1.0 + nrm(ks[7], (DEPTH, D_MODEL), 0.05),
        "w_gate": nrm(ks[8], (DEPTH, D_MODEL, D_FF), D_MODEL ** -0.5),
        "w_up": nrm(ks[9], (DEPTH, D_MODEL, D_FF), D_MODEL ** -0.5),
        "w_down": nrm(ks[10], (DEPTH, D_FF, D_MODEL), D_FF ** -0.5),
        "ln_post_ffn": 1.0 + nrm(ks[11], (DEPTH, D_MODEL), 0.05),
    }


def reference(x, ln_pre_mix, w_in, w_pool, pool_scale, w_out, ln_post_mix,
              ln_pre_ffn, w_gate, w_up, w_down, ln_post_ffn):
    B, S, _ = x.shape
    pos = jnp.arange(S)
    for l in range(DEPTH):
        h = rms_norm(x, ln_pre_mix[l])
        proj = h @ w_in[l]
        u_pool = proj[..., :POOL_WIDTH]
        q = proj[..., POOL_WIDTH:POOL_WIDTH + ATTN_WIDTH].reshape(B, S, N_HEADS, HEAD_DIM)
        k = proj[..., POOL_WIDTH + ATTN_WIDTH:POOL_WIDTH + 2 * ATTN_WIDTH].reshape(B, S, N_HEADS, HEAD_DIM)
        v = proj[..., POOL_WIDTH + 2 * ATTN_WIDTH:].reshape(B, S, N_HEADS, HEAD_DIM)
        q, k = rope(q, pos), rope(k, pos)
        pool_out = multi_scale_pool(u_pool, w_pool[l], pool_scale[l])
        attn_out = dilated_attention(q, k, v).reshape(B, S, ATTN_WIDTH)
        mix = jnp.concatenate([pool_out, attn_out], axis=-1) @ w_out[l]
        x = x + rms_norm(mix, ln_post_mix[l])
        h = rms_norm(x, ln_pre_ffn[l])
        f = (jax.nn.silu(h @ w_gate[l]) * (h @ w_up[l])) @ w_down[l]
        x = x + rms_norm(f, ln_post_ffn[l])
    return x
```

```cpp
#include <hip/hip_runtime.h>
#include <hip/hip_cooperative_groups.h>
#include <cstdio>
#include <cstdint>
namespace cg = cooperative_groups;
namespace pg8 {
#define PG8_LAS __attribute__((address_space(3)))
typedef unsigned short bf16_t;
typedef short bf16x8 __attribute__((ext_vector_type(8)));
typedef float f32x4 __attribute__((ext_vector_type(4)));
typedef unsigned u32x4 __attribute__((ext_vector_type(4)));
constexpr int BM = 256, BK = 64, HALF = 128, HTB = HALF * BK * 2  , STAGE_BYTES = 8 * HTB, NXCD = 8, WGM = 8;

__host__ __device__ __forceinline__ int lds_byte(int r, int c) { const int st = (r >> 4) * 2 + (c >> 5), rr = r & 15, cc = c & 31, ob = rr * 64 + cc * 2; return st * 1024 + (ob ^ (((ob >> 9) & 1) << 5)); }
__host__ __device__ __forceinline__ void stage_rc(int b, int& R, int& C) { const int st = b / 1024, sb = b % 1024, swz = sb ^ (((sb >> 9) & 1) << 5); R = (st >> 1) * 16 + swz / 64; C = (st & 1) * 32 + (swz % 64) / 2; }
__host__ __device__ __forceinline__ int perm32(int rho) { const int n = rho >> 4, i = rho & 15; return 8 * (i >> 2) + 4 * n + (i & 3); }

struct Unit { int pm, pn; };
struct Gemm { const bf16_t* A; const bf16_t* Bt; int M, N, K; };

struct StaticOrder {
    int nM, nN, nwg, G, c;
    __host__ __device__ void init(int M, int N, int G_, int c_) { nM = M / BM; nN = N / BM; nwg = nM * nN; G = G_; c = c_; }
    __host__ __device__ bool next(int i, Unit& u) const {
        const long L = (long)i * G + c; if (L >= nwg) return false;
        int wgid = (int)L; { const int q = nwg / NXCD, r = nwg % NXCD, xcd = wgid % NXCD, off = wgid / NXCD; wgid = (xcd < r ? xcd * (q + 1) : r * (q + 1) + (xcd - r) * q) + off; }
        const int nig = WGM * nN, gid = wgid / nig, fm = gid * WGM, gsz = (nM - fm) < WGM ? (nM - fm) : WGM;
        u.pm = fm + ((wgid % nig) % gsz); u.pn = (wgid % nig) / gsz; return true;
    }
    __device__ __forceinline__ void a_ready(const Unit&) const {}
    __device__ __forceinline__ void done(const Unit&) const {}
};

__device__ __forceinline__ unsigned cvt_pk_bf16(float lo, float hi) { unsigned r; asm volatile("v_cvt_pk_bf16_f32 %0, %1, %2" : "=v"(r) : "v"(lo), "v"(hi)); return r; }
typedef float f32x2 __attribute__((ext_vector_type(2)));
struct EpiProj {
    static constexpr bool PERM = true, AFTER_DRAIN = false;
    bf16_t* UP; bf16_t* Q; bf16_t* Kk; bf16_t* V; const float* cs; float qscale;
    __device__ __forceinline__ void operator()(const f32x4 (&acc)[2][2][4][2], const Unit& u, int wr, int wc, int fr, int fq) const {
        const int pn = u.pn;
        bf16_t* base; int colt; bool rope = false; float sc = 1.f;
        if (pn == 0) { base = UP; colt = 0; }
        else if (pn < 4) { base = Q; colt = (pn - 1) * 256; rope = true; sc = qscale; }
        else if (pn < 7) { base = Kk; colt = (pn - 4) * 256; rope = true; }
        else { base = V; colt = (pn - 7) * 256; }
        const int row0 = u.pm * BM + wr * 64 + fr;
        const int col0 = colt + wc * 32 + 8 * fq;
        const int j = 4 * (wc & 1) + fq;
        float frq[4];
#pragma unroll
        for (int i = 0; i < 4; ++i) frq[i] = __builtin_amdgcn_exp2f(-(float)(4 * j + i) * (13.287712379549449f / 32.0f)) * 0.15915494309189535f;
#pragma unroll
        for (int ai = 0; ai < 2; ++ai)
#pragma unroll
            for (int m = 0; m < 4; ++m) {
                const int row = row0 + ai * HALF + m * 16;
                f32x4 c4 = (f32x4){1.f, 1.f, 1.f, 1.f}, s4 = (f32x4){0.f, 0.f, 0.f, 0.f};
                if (rope) {
                    const float pos = (float)(row & 8191);
#pragma unroll
                    for (int i = 0; i < 4; ++i) { float rev = pos * frq[i]; rev = rev - __builtin_floorf(rev); c4[i] = __builtin_amdgcn_cosf(rev); s4[i] = __builtin_amdgcn_sinf(rev); }
                }
#pragma unroll
                for (int bj = 0; bj < 2; ++bj) {
                    const int col = col0 + bj * HALF;
                    bf16_t* dst = (pn == 0) ? base + (size_t)row * 256 + col : base + (((size_t)(row >> 13) * 12 + (col >> 6)) * 8192 + (row & 8191)) * 64 + (col & 63);
                    const f32x4 v0 = acc[ai][bj][m][0], v1 = acc[ai][bj][m][1];
                    const f32x4 o0 = (v0 * c4 - v1 * s4) * sc, o1 = (v1 * c4 + v0 * s4) * sc;
                    u32x4 w; w.x = cvt_pk_bf16(o0[0], o0[1]); w.y = cvt_pk_bf16(o0[2], o0[3]); w.z = cvt_pk_bf16(o1[0], o1[1]); w.w = cvt_pk_bf16(o1[2], o1[3]);
                    *(u32x4*)dst = w;
                }
            }
    }
};
struct EpiPlain {
    static constexpr bool PERM = true, AFTER_DRAIN = false;
    bf16_t* O; int ldc;
    __device__ __forceinline__ void operator()(const f32x4 (&acc)[2][2][4][2], const Unit& u, int wr, int wc, int fr, int fq) const {
        const int row0 = u.pm * BM + wr * 64 + fr, col0 = u.pn * BM + wc * 32 + 8 * fq;
#pragma unroll
        for (int ai = 0; ai < 2; ++ai)
#pragma unroll
            for (int m = 0; m < 4; ++m) {
                bf16_t* rowp = O + (size_t)(row0 + ai * HALF + m * 16) * ldc + col0;
#pragma unroll
                for (int bj = 0; bj < 2; ++bj) {
                    const f32x4 v0 = acc[ai][bj][m][0], v1 = acc[ai][bj][m][1];
                    u32x4 w; w.x = cvt_pk_bf16(v0[0], v0[1]); w.y = cvt_pk_bf16(v0[2], v0[3]); w.z = cvt_pk_bf16(v1[0], v1[1]); w.w = cvt_pk_bf16(v1[2], v1[3]);
                    *(u32x4*)(rowp + bj * HALF) = w;
                }
            }
    }
};
struct EpiSwiGLU {
    static constexpr bool PERM = true, AFTER_DRAIN = false;
    bf16_t* O; int ldc;
    __device__ __forceinline__ void operator()(const f32x4 (&acc)[2][2][4][2], const Unit& u, int wr, int wc, int fr, int fq) const {
        typedef unsigned u32x2 __attribute__((ext_vector_type(2)));
        const int row0 = u.pm * BM + wr * 64 + fr, col0 = u.pn * 128 + wc * 16 + 4 * fq;
#pragma unroll
        for (int ai = 0; ai < 2; ++ai)
#pragma unroll
            for (int m = 0; m < 4; ++m) {
                bf16_t* rowp = O + (size_t)(row0 + ai * HALF + m * 16) * ldc + col0;
#pragma unroll
                for (int bj = 0; bj < 2; ++bj) {
                    const f32x4 g = acc[ai][bj][m][0], up = acc[ai][bj][m][1];
                    float a[4];
#pragma unroll
                    for (int i = 0; i < 4; ++i) { const float e = __builtin_amdgcn_exp2f(g[i] * -1.4426950408889634f); a[i] = g[i] * __builtin_amdgcn_rcpf(1.0f + e) * up[i]; }
                    u32x2 w; w.x = cvt_pk_bf16(a[0], a[1]); w.y = cvt_pk_bf16(a[2], a[3]);
                    *(u32x2*)(rowp + bj * 64) = w;
                }
            }
    }
};
template <class Epi, class Sched, bool ALIGN_EPI = false, bool SP2 = false>
__device__ __forceinline__ void gemm_phase(PG8_LAS unsigned char* lds, const Gemm g, const Sched& S, const Epi& E) {
    const int tid = threadIdx.x, wid = __builtin_amdgcn_readfirstlane(tid >> 6), lane = tid & 63, wr = wid >> 2, wc = wid & 3, fr = lane & 15, fq = lane >> 4;
    const int K = g.K, nt = K / BK;
    unsigned voffA[2], voffB[2];
#pragma unroll
    for (int i = 0; i < 2; ++i) { int R, C; stage_rc(tid * 16 + i * 8192, R, C); const int Rb = Epi::PERM ? ((R & ~31) + perm32(R & 31)) : R;
        voffA[i] = (unsigned)(R * K + C) * 2u; voffB[i] = (unsigned)(Rb * K + C) * 2u; }
    const size_t kstep = (size_t)(BK * 2);
    const size_t hstep = (size_t)HALF * K * 2;
    const size_t tstep = 2 * hstep;
    const unsigned ldsw = (unsigned)wid * 1024u;
    const int aoff = lds_byte(wr * 64 + fr, fq * 8), boff = lds_byte(wc * 32 + fr, fq * 8);
#define PG8_SA(b, h) (((b) * 2 + (h)) * HTB)
#define PG8_SB(b, h) ((4 + (b) * 2 + (h)) * HTB)
#define PG8_STAGE(bufoff, gbase, voff) do { _Pragma("unroll") for (int _i = 0; _i < 2; ++_i) \
        __builtin_amdgcn_global_load_lds((const unsigned*)((const char*)(gbase) + (voff)[_i]), (PG8_LAS unsigned*)(lds + (bufoff) + ldsw + _i * 8192), 16, 0, 0); } while (0)
#define PG8_LDA(dst, b, h) do { _Pragma("unroll") for (int m = 0; m < 4; ++m) _Pragma("unroll") for (int k = 0; k < 2; ++k) dst[m][k] = *(const PG8_LAS bf16x8*)(lds + PG8_SA(b, h) + aoff + m * 2048 + k * 1024); } while (0)
#define PG8_LDB(dst, b, h) do { _Pragma("unroll") for (int n = 0; n < 2; ++n) _Pragma("unroll") for (int k = 0; k < 2; ++k) dst[n][k] = *(const PG8_LAS bf16x8*)(lds + PG8_SB(b, h) + boff + n * 2048 + k * 1024); } while (0)
#define PG8_MMA(ai, bj, At, Bt) do { __builtin_amdgcn_s_setprio(1); _Pragma("unroll") for (int m = 0; m < 4; ++m) _Pragma("unroll") for (int n = 0; n < 2; ++n) _Pragma("unroll") for (int k = 0; k < 2; ++k) \
        acc[ai][bj][m][n] = __builtin_amdgcn_mfma_f32_16x16x32_bf16(Bt[n][k], At[m][k], acc[ai][bj][m][n], 0, 0, 0); __builtin_amdgcn_s_setprio(0); } while (0)
#define PG8_WAIT_V(n) asm volatile("s_waitcnt vmcnt(" #n ")" ::: "memory")
#define PG8_WAIT_L(n) asm volatile("s_waitcnt lgkmcnt(" #n ")" ::: "memory")
#define PG8_BAR __builtin_amdgcn_s_barrier()
#define PG8_SCHED __builtin_amdgcn_sched_barrier(0)
    Unit cur, nxt; int ui = 0;
    if (!S.next(0, cur)) return;
    f32x4 acc[2][2][4][2];
#pragma unroll
    for (int a = 0; a < 2; ++a)
#pragma unroll
        for (int b = 0; b < 2; ++b)
#pragma unroll
            for (int m = 0; m < 4; ++m)
#pragma unroll
                for (int n = 0; n < 2; ++n) acc[a][b][m][n] = (f32x4){0.f, 0.f, 0.f, 0.f};
    bf16x8 At[4][2], B0[2][2], B1[2][2];
    const char* cA = (const char*)g.A + (size_t)cur.pm * tstep; const char* cB = (const char*)g.Bt + (size_t)cur.pn * tstep;
    S.a_ready(cur);
    if constexpr (SP2) {
        PG8_STAGE(PG8_SB(0, 0), cB, voffB); PG8_STAGE(PG8_SB(0, 1), cB + hstep, voffB); PG8_STAGE(PG8_SA(0, 0), cA, voffA); PG8_STAGE(PG8_SA(0, 1), cA + hstep, voffA);
        if (wr == 1) PG8_BAR;
        PG8_WAIT_V(2); PG8_BAR;
        PG8_STAGE(PG8_SB(1, 0), cB + kstep, voffB); PG8_STAGE(PG8_SA(1, 0), cA + kstep, voffA); PG8_STAGE(PG8_SB(1, 1), cB + hstep + kstep, voffB);
        PG8_WAIT_V(6); PG8_BAR;
    } else {
        PG8_STAGE(PG8_SB(0, 0), cB, voffB); PG8_STAGE(PG8_SA(0, 0), cA, voffA); PG8_STAGE(PG8_SB(0, 1), cB + hstep, voffB); PG8_STAGE(PG8_SA(0, 1), cA + hstep, voffA);
        if (wr == 1) PG8_BAR;
        PG8_WAIT_V(4); PG8_BAR;
        PG8_STAGE(PG8_SB(1, 0), cB + kstep, voffB); PG8_STAGE(PG8_SA(1, 0), cA + kstep, voffA); PG8_STAGE(PG8_SB(1, 1), cB + hstep + kstep, voffB);
        PG8_WAIT_V(6); PG8_BAR;
    }
    for (;;) {
        const bool has_next = S.next(ui + 1, nxt);
        const char* nA = has_next ? (const char*)g.A + (size_t)nxt.pm * tstep : cA; const char* nB = has_next ? (const char*)g.Bt + (size_t)nxt.pn * tstep : cB;
        for (int t = 0; t < nt; t += 2) {
            const bool last = (t == nt - 2);
            const char* a1 = cA + (size_t)(t + 1) * kstep;
            const char* a2 = last ? nA : cA + (size_t)(t + 2) * kstep; const char* b2 = last ? nB : cB + (size_t)(t + 2) * kstep;
            const char* a3 = a2 + kstep; const char* b3 = b2 + kstep;
            if (last && has_next) S.a_ready(nxt);
            if constexpr (SP2) {
            PG8_LDB(B0, 0, 0); PG8_LDB(B1, 0, 1); PG8_SCHED; PG8_LDA(At, 0, 0); PG8_STAGE(PG8_SA(1, 1), a1 + hstep, voffA);
            PG8_WAIT_V(8); PG8_WAIT_L(0); PG8_BAR; PG8_MMA(0, 0, At, B0); PG8_MMA(0, 1, At, B1); PG8_BAR; PG8_SCHED;
            PG8_LDA(At, 0, 1); PG8_STAGE(PG8_SB(0, 0), b2, voffB); PG8_STAGE(PG8_SB(0, 1), b2 + hstep, voffB); PG8_STAGE(PG8_SA(0, 0), a2, voffA);
            PG8_WAIT_V(8); PG8_WAIT_L(0); PG8_BAR; PG8_MMA(1, 0, At, B0); PG8_MMA(1, 1, At, B1); PG8_BAR; PG8_SCHED;
            PG8_LDB(B0, 1, 0); PG8_LDB(B1, 1, 1); PG8_SCHED; PG8_LDA(At, 1, 0); PG8_STAGE(PG8_SA(0, 1), a2 + hstep, voffA);
            PG8_WAIT_V(8); PG8_WAIT_L(0); PG8_BAR; PG8_MMA(0, 0, At, B0); PG8_MMA(0, 1, At, B1); PG8_BAR; PG8_SCHED;
            PG8_LDA(At, 1, 1); PG8_STAGE(PG8_SB(1, 0), b3, voffB); PG8_STAGE(PG8_SB(1, 1), b3 + hstep, voffB); PG8_STAGE(PG8_SA(1, 0), a3, voffA);
            PG8_WAIT_V(8); PG8_WAIT_L(0); PG8_BAR; PG8_MMA(1, 0, At, B0); PG8_MMA(1, 1, At, B1); PG8_BAR; PG8_SCHED;
            } else {
            PG8_LDB(B0, 0, 0); PG8_SCHED; PG8_LDA(At, 0, 0); PG8_STAGE(PG8_SA(1, 1), a1 + hstep, voffA);
            PG8_WAIT_L(8); PG8_BAR; PG8_WAIT_L(0); PG8_MMA(0, 0, At, B0); PG8_BAR; PG8_SCHED;
            PG8_LDB(B1, 0, 1); PG8_STAGE(PG8_SB(0, 0), b2, voffB);
            PG8_BAR; PG8_WAIT_L(0); PG8_MMA(0, 1, At, B1); PG8_BAR;
            PG8_LDA(At, 0, 1); PG8_STAGE(PG8_SA(0, 0), a2, voffA);
            PG8_BAR; PG8_WAIT_L(0); PG8_MMA(1, 0, At, B0); PG8_BAR; PG8_SCHED;
            PG8_STAGE(PG8_SB(0, 1), b2 + hstep, voffB);
            PG8_WAIT_V(6); PG8_BAR; PG8_MMA(1, 1, At, B1); PG8_BAR;
            PG8_LDB(B0, 1, 0); PG8_SCHED; PG8_LDA(At, 1, 0); PG8_STAGE(PG8_SA(0, 1), a2 + hstep, voffA);
            PG8_WAIT_L(8); PG8_BAR; PG8_WAIT_L(0); PG8_MMA(0, 0, At, B0); PG8_BAR; PG8_SCHED;
            PG8_LDB(B1, 1, 1); PG8_STAGE(PG8_SB(1, 0), b3, voffB);
            PG8_BAR; PG8_WAIT_L(0); PG8_MMA(0, 1, At, B1); PG8_BAR;
            PG8_LDA(At, 1, 1); PG8_STAGE(PG8_SA(1, 0), a3, voffA);
            PG8_BAR; PG8_WAIT_L(0); PG8_MMA(1, 0, At, B0); PG8_BAR; PG8_SCHED;
            PG8_STAGE(PG8_SB(1, 1), b3 + hstep, voffB);
            PG8_WAIT_V(6); PG8_BAR; PG8_MMA(1, 1, At, B1); PG8_BAR;
            }
        }
        if constexpr (ALIGN_EPI) { if (wr == 0) PG8_BAR; }
        if constexpr (!Epi::AFTER_DRAIN) { E(acc, cur, wr, wc, fr, fq); S.done(cur); }
        if (!has_next) break;
#pragma unroll
        for (int a = 0; a < 2; ++a)
#pragma unroll
            for (int b = 0; b < 2; ++b)
#pragma unroll
                for (int m = 0; m < 4; ++m)
#pragma unroll
                    for (int n = 0; n < 2; ++n) acc[a][b][m][n] = (f32x4){0.f, 0.f, 0.f, 0.f};
        cur = nxt; cA = nA; cB = nB; ++ui;
        if constexpr (ALIGN_EPI) { if (wr == 1) PG8_BAR; }
    }
    PG8_WAIT_V(0);
    if constexpr (!ALIGN_EPI) { if (wr == 0) PG8_BAR; }
    PG8_BAR;
    if constexpr (Epi::AFTER_DRAIN) { E.fused(acc, cur, wr, wc, fr, fq, lds, wid, lane); S.done(cur); }
#undef PG8_SA
#undef PG8_SB
#undef PG8_STAGE
#undef PG8_LDA
#undef PG8_LDB
#undef PG8_MMA
#undef PG8_WAIT_V
#undef PG8_WAIT_L
#undef PG8_BAR
#undef PG8_SCHED
}
}
constexpr int NWAVES = 8;
constexpr int BATCH = 4, SEQ = 8192, DM = 1024, M = BATCH * SEQ;
constexpr int PW = 256, AW = 768, NH = 12, HD = 64, NPROJ = PW + 3 * AW;
constexpr int DFF = 2816, NGU = 2 * DFF;
constexpr float EPS = 1e-6f;
constexpr float QSCALE = 0.125f * 1.4426950408889634f;
constexpr size_t MiB = 1u << 20;
constexpr size_t WS_CS = 1 * MiB;
constexpr size_t WS_WIN = 4 * MiB;
constexpr size_t WS_WOUT = 10 * MiB;
constexpr size_t WS_WGU = 12 * MiB;
constexpr size_t WS_WDN = 24 * MiB;
constexpr size_t WS_H = 32 * MiB;
constexpr size_t WS_MIX = 96 * MiB;
constexpr size_t WS_UP = 160 * MiB;
constexpr size_t WS_Q = 176 * MiB, WS_K = 224 * MiB, WS_V = 272 * MiB;
constexpr size_t WS_MC = 320 * MiB;
constexpr size_t WS_ACT = 160 * MiB;
constexpr size_t WS_LSE = 384 * MiB;
constexpr size_t WS_P16 = 388 * MiB;
constexpr size_t WS_RMS0 = 436 * MiB;
constexpr size_t WS_END = 437 * MiB;
static_assert(WS_ACT + (size_t)M * DFF * 2 <= WS_END, "ws map");
constexpr int RING_BYTES = 131072;
constexpr int LDS_BYTES = 147456;
constexpr int L_WV = 0;
constexpr int L_WV_STRIDE = 16384 + 512;
static_assert(L_WV + NWAVES * L_WV_STRIDE <= LDS_BYTES, "attention LDS");

#define GAS __attribute__((address_space(1)))
#define LAS __attribute__((address_space(3)))
typedef unsigned short bf16;
typedef unsigned v4u __attribute__((ext_vector_type(4)));
typedef unsigned v2u __attribute__((ext_vector_type(2)));
typedef float f32x4 __attribute__((ext_vector_type(4)));
typedef float f32x16 __attribute__((ext_vector_type(16)));
typedef short bf16x8 __attribute__((ext_vector_type(8)));
typedef short s16x4 __attribute__((ext_vector_type(4)));
#define LDS_WAIT() asm volatile("s_waitcnt lgkmcnt(0)" ::: "memory")
__device__ __forceinline__ unsigned f2bf(float f) { unsigned u = __builtin_bit_cast(unsigned, f); return (u + 0x7fffu + ((u >> 16) & 1u)) >> 16; }
__device__ __forceinline__ unsigned pk2(float lo, float hi) { return f2bf(lo) | (f2bf(hi) << 16); }
__device__ __forceinline__ float bf2f(unsigned short b) { return __builtin_bit_cast(float, (unsigned)b << 16); }
__device__ __forceinline__ float wave_sum(float v) {
#pragma unroll
    for (int o = 1; o < 64; o <<= 1) v += __shfl_xor(v, o);
    return v;
}

typedef GAS unsigned gu32;
#define RLX_AGENT __ATOMIC_RELAXED, __HIP_MEMORY_SCOPE_AGENT
#define XB_TMO      128
#define XB_XCNT(j)  (256  + 64 * (j))
#define XB_XSUB(j)  (1280 + 64 * (j))
#define XB_XGEN(j)  (2304 + 64 * (j))
#define XB_TOP      3328
#define XB_TOPGEN   3392
#define XCD_BAR_WORDS 3456
#define XB_SPIN_CAP (1u << 18)

__device__ __forceinline__ unsigned xb_ld(unsigned* p)              { return __hip_atomic_load(p, __ATOMIC_RELAXED, __HIP_MEMORY_SCOPE_AGENT); }
__device__ __forceinline__ unsigned xb_add(unsigned* p, unsigned v) { return __hip_atomic_fetch_add(p, v, __ATOMIC_RELAXED, __HIP_MEMORY_SCOPE_AGENT); }
__device__ __forceinline__ unsigned xb_xcc_id() { return (unsigned)__builtin_amdgcn_s_getreg((3 << 11) | 20) & 0xFu; }
#define XB_SPIN(cond, bar) do { unsigned _sp = 0; while (cond) { __builtin_amdgcn_s_sleep(1); \
    if ((++_sp & 255u) == 0u) { if (xb_ld(&(bar)[XB_TMO])) break; if (_sp > XB_SPIN_CAP) { atomicAdd(&(bar)[XB_TMO], 1u); break; } } } } while (0)

struct XcdBarrier {
    unsigned* bar; unsigned x;
    volatile LAS unsigned* st;
};

__device__ __forceinline__ XcdBarrier xcd_barrier_post(unsigned* bar, volatile LAS unsigned* st) {
    XcdBarrier b; b.bar = bar; b.x = xb_xcc_id(); b.st = st;
    if (threadIdx.x == 0) (void)xb_add(&bar[XB_XCNT(b.x)], 1u);
    return b;
}
__device__ __forceinline__ void xcd_barrier_complete(unsigned* bar, unsigned x, unsigned& nloc, unsigned& nx) {
    const unsigned G = gridDim.x * gridDim.y * gridDim.z;
    unsigned sum, cnt, mine, sp = 0u;
    for (;;) {
        sum = 0u; cnt = 0u; mine = 0u;
#pragma unroll
        for (unsigned j = 0; j < 16; ++j) { const unsigned c = xb_ld(&bar[XB_XCNT(j)]); sum += c; cnt += (c > 0u) ? 1u : 0u; mine = (j == x) ? c : mine; }
        if (sum == G) break;
        __builtin_amdgcn_s_sleep(1);
        if ((++sp & 255u) == 0u) { if (xb_ld(&bar[XB_TMO])) break; if (sp > XB_SPIN_CAP) { atomicAdd(&bar[XB_TMO], 1u); break; } }
    }
    nloc = mine > 0u ? mine : 1u; nx = cnt > 0u ? cnt : 1u;
}

__device__ __forceinline__ void xcd_barrier(const XcdBarrier& b) {
    asm volatile("s_waitcnt vmcnt(0)" ::: "memory");
    __syncthreads();
    if (threadIdx.x == 0) {
        unsigned* bar = b.bar;
        __builtin_amdgcn_s_waitcnt(0);
        unsigned nloc = b.st[0], nx = b.st[1];
        if (nloc == 0u) { xcd_barrier_complete(bar, b.x, nloc, nx); b.st[0] = nloc; b.st[1] = nx; }
        const unsigned old = xb_add(&bar[XB_XSUB(b.x)], 1u);
        const unsigned gen = old / nloc;
        if (old + 1u == (gen + 1u) * nloc) {
            __builtin_amdgcn_fence(__ATOMIC_RELEASE, "agent");
            asm volatile("s_waitcnt vmcnt(0)" ::: "memory");
            const unsigned og = xb_add(&bar[XB_TOP], 1u);
            const unsigned tg = og / nx;
            if (og + 1u == (tg + 1u) * nx) xb_add(&bar[XB_TOPGEN], 1u);
            else XB_SPIN(xb_ld(&bar[XB_TOPGEN]) == tg, bar);
            __builtin_amdgcn_fence(__ATOMIC_ACQUIRE, "agent");
            xb_add(&bar[XB_XGEN(b.x)], 1u);
            asm volatile("s_waitcnt vmcnt(0)" ::: "memory");
        } else {
            XB_SPIN(xb_ld(&bar[XB_XGEN(b.x)]) == gen, bar);
            __builtin_amdgcn_fence(__ATOMIC_ACQUIRE, "agent");
            asm volatile("s_waitcnt vmcnt(0)" ::: "memory");
        }
    }
    __syncthreads();
}

__device__ __forceinline__ void p0_transpose_item(const float* colp, int Ns, int k0, bf16* WT, int K, int n0, LAS float* scr, int lane) {
#pragma unroll 8
    for (int i = 0; i < 32; ++i) { const int kk = 2 * i + (lane >> 5); scr[kk * 33 + (lane & 31)] = __builtin_nontemporal_load(colp + (size_t)(k0 + kk) * Ns); }
    LDS_WAIT(); asm volatile("" ::: "memory");
    const int c = lane & 7;
#pragma unroll
    for (int j = 0; j < 4; ++j) { const int n = (lane >> 3) + 8 * j; const LAS float* s = scr + (8 * c) * 33 + n;
        v4u o; o.x = pk2(s[0 * 33], s[1 * 33]); o.y = pk2(s[2 * 33], s[3 * 33]); o.z = pk2(s[4 * 33], s[5 * 33]); o.w = pk2(s[6 * 33], s[7 * 33]);
        *(v4u*)(WT + (size_t)(n0 + n) * K + k0 + 8 * c) = o; }
    LDS_WAIT(); asm volatile("" ::: "memory");
}
__device__ __forceinline__ int inproj_src_col(int n) {
    if (n < PW || n >= PW + 2 * AW) return n;
    const int base = PW + ((n - PW) & ~63), p = (n - PW) & 63;
    return base + 4 * (p >> 3) + (p & 3) + 32 * ((p >> 2) & 1);
}
template <int NR>
__device__ __forceinline__ void rms_rows_to_bf16(const float* __restrict__ x, const float* __restrict__ g, bf16* __restrict__ H, float* __restrict__ rms0, int m0, int lane) {
    f32x4 v[NR][4];
#pragma unroll
    for (int r = 0; r < NR; ++r)
#pragma unroll
        for (int j = 0; j < 4; ++j) v[r][j] = __builtin_nontemporal_load((const f32x4*)(x + (size_t)(m0 + r) * DM) + lane + 64 * j);
    f32x4 gg[4];
#pragma unroll
    for (int j = 0; j < 4; ++j) gg[j] = ((const f32x4*)g + lane)[64 * j];
#pragma unroll
    for (int r = 0; r < NR; ++r) {
        float s = 0.f;
#pragma unroll
        for (int j = 0; j < 4; ++j) s += (v[r][j].x * v[r][j].x + v[r][j].y * v[r][j].y) + (v[r][j].z * v[r][j].z + v[r][j].w * v[r][j].w);
        const float rms = sqrtf(wave_sum(s) * (1.f / DM) + EPS), rstd = 1.0f / rms;
        if (lane == 0) rms0[m0 + r] = rms;
        unsigned long long* o8 = (unsigned long long*)(H + (size_t)(m0 + r) * DM) + lane;
#pragma unroll
        for (int j = 0; j < 4; ++j) { const f32x4 y = v[r][j] * rstd * gg[j];
            o8[64 * j] = (unsigned long long)pk2(y.x, y.y) | ((unsigned long long)pk2(y.z, y.w) << 32); }
    }
}
__device__ __forceinline__ void p0_prologue(const float* x, const float* ln1, const float* w_in, const float* w_out, const float* w_gate, const float* w_up, const float* w_down,
                                            unsigned char* ws, LAS unsigned char* lds, int gw, int NGW, int wave, int lane, int gtid, int GT) {
    LAS float* scr = (LAS float*)(lds + wave * 16384);
    bf16* Win = (bf16*)(ws + WS_WIN); bf16* Wout = (bf16*)(ws + WS_WOUT); bf16* Wgu = (bf16*)(ws + WS_WGU); bf16* Wdn = (bf16*)(ws + WS_WDN);
    constexpr int I_IN = (DM / 64) * (NPROJ / 32), I_OUT = (DM / 64) * (DM / 32), I_GU = (DM / 64) * (NGU / 32), I_DN = (DFF / 64) * (DM / 32);
    constexpr int NITEMS = I_IN + I_OUT + I_GU + I_DN;
    for (int it = gw; it < NITEMS; it += NGW) {
        int r = it;
        if (r < I_IN) { const int nblk = NPROJ / 32, kb = r / nblk, nb = r % nblk; const int n = nb * 32 + (lane & 31);
            p0_transpose_item(w_in + inproj_src_col(n), NPROJ, kb * 64, Win, DM, nb * 32, scr, lane); continue; } r -= I_IN;
        if (r < I_OUT) { const int nblk = DM / 32, kb = r / nblk, nb = r % nblk; const int n = nb * 32 + (lane & 31);
            p0_transpose_item(w_out + n, DM, kb * 64, Wout, DM, nb * 32, scr, lane); continue; } r -= I_OUT;
        if (r < I_GU) { const int nblk = NGU / 32, kb = r / nblk, nb = r % nblk; const int n = nb * 32 + (lane & 31);
            const float* src = ((n >> 2) & 1) ? w_up : w_gate; const int col = 4 * (n >> 3) + (n & 3);
            p0_transpose_item(src + col, DFF, kb * 64, Wgu, DM, nb * 32, scr, lane); continue; } r -= I_GU;
        { const int nblk = DM / 32, kb = r / nblk, nb = r % nblk; const int n = nb * 32 + (lane & 31);
            p0_transpose_item(w_down + n, DM, kb * 64, Wdn, DFF, nb * 32, scr, lane); }
    }
    bf16* H = (bf16*)(ws + WS_H);
    for (int m = 4 * gw; m < M; m += 4 * NGW) rms_rows_to_bf16<4>(x, ln1, H, (float*)(ws + WS_RMS0), m, lane);
}

__device__ __forceinline__ unsigned cvtpk(float lo, float hi) { unsigned r; asm volatile("v_cvt_pk_bf16_f32 %0, %1, %2" : "=v"(r) : "v"(lo), "v"(hi)); return r; }
__device__ __forceinline__ int crow(int r, int hi) { return (r & 3) + 8 * (r >> 2) + 4 * hi; }
template <int GI>
__device__ __forceinline__ void pool_d_tile(const bf16* __restrict__ up, const float* __restrict__ wg, int T0, int pos0, LAS unsigned char* Dt, int lane, bf16x8 (&wb)[2][4]) {
    constexpr int WIN = 2 << GI;
    const int r32 = lane & 31, hi = lane >> 5;
    unsigned short ur[79];
#pragma unroll
    for (int k = 1; k < WIN; ++k) ur[15 - k] = (pos0 - k >= 0) ? up[(ptrdiff_t)(T0 - k) * PW] : (unsigned short)0;
#pragma unroll
    for (int j = 0; j < 64; ++j) ur[15 + j] = up[(size_t)(T0 + j) * PW];
    float wr[2][4][8];
#pragma unroll
    for (int nh = 0; nh < 2; ++nh)
#pragma unroll
        for (int k0 = 0; k0 < 4; ++k0) { const float* wp = wg + (size_t)(16 * k0 + 8 * hi) * 64 + 32 * nh + r32;
#pragma unroll
            for (int j = 0; j < 8; ++j) wr[nh][k0][j] = wp[64 * j]; }
    float s = 0.f;
#pragma unroll
    for (int k = 1; k < WIN; ++k) s += bf2f(ur[15 - k]);
#pragma unroll
    for (int j = 0; j < 64; ++j) {
        const int pos = pos0 + j; const float c = bf2f(ur[15 + j]);
        s += c;
        const int cnt = (pos + 1 < WIN) ? pos + 1 : WIN;
        const float d = s / (float)cnt - c;
        s -= bf2f(ur[16 + j - WIN]);
        *(LAS bf16*)(Dt + j * 128 + (((lane >> 3) ^ ((j >> 1) & 7)) * 16) + (lane & 7) * 2) = (bf16)cvtpk(d, 0.f);
    }
#pragma unroll
    for (int nh = 0; nh < 2; ++nh)
#pragma unroll
        for (int k0 = 0; k0 < 4; ++k0) { v4u w; w.x = cvtpk(wr[nh][k0][0], wr[nh][k0][1]); w.y = cvtpk(wr[nh][k0][2], wr[nh][k0][3]); w.z = cvtpk(wr[nh][k0][4], wr[nh][k0][5]); w.w = cvtpk(wr[nh][k0][6], wr[nh][k0][7]);
            wb[nh][k0] = __builtin_bit_cast(bf16x8, w); }
}
__device__ __forceinline__ void pool_item(const bf16* UPb, const float* w_pool, const float* pool_scale, bf16* MC, int item, LAS unsigned char* Dt, int lane) {
    const int g = item & 3, T0 = (item >> 2) * 64, pos0 = T0 & (SEQ - 1);
    const int r32 = lane & 31, hi = lane >> 5;
    const bf16* up = UPb + g * 64 + lane; const float* wg = w_pool + (size_t)g * 4096;
    const float ps0 = pool_scale[g * 64 + r32], ps1 = pool_scale[g * 64 + 32 + r32];
    bf16x8 wb[2][4];
    if (g == 0) pool_d_tile<0>(up, wg, T0, pos0, Dt, lane, wb);
    else if (g == 1) pool_d_tile<1>(up, wg, T0, pos0, Dt, lane, wb);
    else if (g == 2) pool_d_tile<2>(up, wg, T0, pos0, Dt, lane, wb);
    else pool_d_tile<3>(up, wg, T0, pos0, Dt, lane, wb);
    f32x16 acc[2][2];
#pragma unroll
    for (int th = 0; th < 2; ++th) { acc[th][0] = f32x16{}; acc[th][1] = f32x16{};
        const int row = 32 * th + r32;
#pragma unroll
        for (int k0 = 0; k0 < 4; ++k0) { const bf16x8 af = *(LAS bf16x8*)(Dt + row * 128 + (((2 * k0 + hi) ^ ((row >> 1) & 7)) * 16));
            acc[th][0] = __builtin_amdgcn_mfma_f32_32x32x16_bf16(af, wb[0][k0], acc[th][0], 0, 0, 0);
            acc[th][1] = __builtin_amdgcn_mfma_f32_32x32x16_bf16(af, wb[1][k0], acc[th][1], 0, 0, 0); } }
#pragma unroll
    for (int th = 0; th < 2; ++th)
#pragma unroll
        for (int rr = 0; rr < 16; ++rr) { const int row = 32 * th + crow(rr, hi);
            *(LAS bf16*)(Dt + row * 128 + r32 * 2) = (bf16)cvtpk(acc[th][0][rr] * ps0, 0.f);
            *(LAS bf16*)(Dt + row * 128 + 64 + r32 * 2) = (bf16)cvtpk(acc[th][1][rr] * ps1, 0.f); }
#pragma unroll
    for (int i = 0; i < 8; ++i) { const int row = i * 8 + (lane >> 3), ch = lane & 7;
        const v4u v = *(LAS v4u*)(Dt + row * 128 + ch * 16);
        *(v4u*)(MC + (size_t)(T0 + row) * DM + g * 64 + ch * 8) = v; }
}

typedef short v4i16_t __attribute__((ext_vector_type(4)));
__device__ __forceinline__ s16x4 vtr(LAS unsigned char* p) { return __builtin_bit_cast(s16x4, __builtin_amdgcn_ds_read_tr16_b64_v4i16((LAS v4i16_t*)p)); }
constexpr int L_KIMG = 0, L_VIMG = 49152, L_WSTG = 98304, L_WSTG_STRIDE = 4096 + 512;
static_assert(L_WSTG + NWAVES * L_WSTG_STRIDE <= LDS_BYTES - 64, "attention LDS map");
struct AUnit { size_t hb, rowb; bf16* PO; float* LO; int ld, res, lbase, g0, h; };
__device__ __forceinline__ void att_issue_K(const bf16* __restrict__ Kg, const AUnit& u, LAS unsigned char* lds, int wave, int lane) {
#pragma unroll
    for (int i = 0; i < 6; ++i) { const int p = wave + 8 * i, g = p >> 2, pc = p & 3;
        const int key = 8 * pc + (lane >> 3), c = (lane & 7) ^ ((key >> 1) & 7);
        int sidx = u.lbase - 128 + 32 * g + key; sidx = sidx < 0 ? 0 : sidx;
        const int tok = (sidx << u.ld) + u.res;
        __builtin_amdgcn_global_load_lds((const unsigned*)(Kg + (u.hb + tok) * HD + c * 8), (LAS unsigned*)(lds + L_KIMG + g * 4096 + pc * 1024), 16, 0, 0); }
}
__device__ __forceinline__ void att_issue_V(const bf16* __restrict__ Vg, const AUnit& u, LAS unsigned char* lds, int wave, int lane) {
#pragma unroll
    for (int i = 0; i < 6; ++i) { const int p = wave + 8 * i, g = p >> 2, pc = p & 3, dh = pc >> 1, kg = pc & 1;
        const int key = 16 * kg + (lane >> 2);
        int sidx = u.lbase - 128 + 32 * g + key; sidx = sidx < 0 ? 0 : sidx;
        const int tok = (sidx << u.ld) + u.res;
        __builtin_amdgcn_global_load_lds((const unsigned*)(Vg + (u.hb + tok) * HD + dh * 32 + (lane & 3) * 8), (LAS unsigned*)(lds + L_VIMG + g * 4096 + dh * 2048 + kg * 1024), 16, 0, 0); }
}
template <bool FINAL>
__device__ __forceinline__ AUnit att_unit_of(int n, int vcu, int G, bf16* P16w, float* L16w, bf16* P4w, float* L4w) {
    AUnit a;
    const int U = FINAL ? vcu + G * n : vcu + G * (n >> 1), cfg = FINAL ? 0 : (n & 1);
    const int bh = U >> 5, u = U & 31, b = bh / NH; a.h = bh % NH;
    a.hb = (size_t)bh * SEQ; a.rowb = (size_t)b * SEQ;
    int blk;
    if (FINAL) { a.ld = 0; a.res = 0; blk = u; a.PO = nullptr; a.LO = nullptr; }
    else if (cfg == 0) { a.ld = 4; a.res = u >> 1; blk = u & 1; a.PO = P16w; a.LO = L16w; }
    else { a.ld = 2; a.res = u >> 3; blk = u & 7; a.PO = P4w; a.LO = L4w; }
    a.lbase = 256 * blk; a.g0 = (blk == 0) ? 4 : 0;
    return a;
}
template <bool FINAL>
__device__ __forceinline__ void att_load_q(const bf16* __restrict__ Qg, const float* __restrict__ L16, const float* __restrict__ L4,
                                           const AUnit& u, int wave, int lane, bf16x8 (&qr)[4], float& lse16, float& lse4) {
    const int r32 = lane & 31, hi = lane >> 5, l0 = u.lbase + 32 * wave;
    const int qtok = ((l0 + r32) << u.ld) + u.res;
    const bf16* qp = Qg + (u.hb + qtok) * HD + hi * 8;
#pragma unroll
    for (int d0 = 0; d0 < 4; ++d0) qr[d0] = *(const bf16x8*)(qp + 16 * d0);
    if (FINAL) { lse16 = L16[(u.rowb + qtok) * NH + u.h]; lse4 = L4[(u.rowb + qtok) * NH + u.h]; }
}
#define ATT_BAR() do { asm volatile("s_waitcnt lgkmcnt(0)" ::: "memory"); __builtin_amdgcn_s_barrier(); asm volatile("" ::: "memory"); } while (0)
template <bool FINAL>
__device__ __forceinline__ void attn_phase(const bf16* __restrict__ Qg, const bf16* __restrict__ Kg, const bf16* __restrict__ Vg, bf16* P16w, float* L16w, bf16* P4w, float* L4w,
                                           bf16* __restrict__ MC, LAS unsigned char* lds, int vcu, int G, int wave, int lane) {
    const int r32 = lane & 31, hi = lane >> 5;
    const int NU = BATCH * NH * 32;
    if (vcu >= NU) return;
    const int nk = (NU - vcu + G - 1) / G, N = FINAL ? nk : 2 * nk;
    AUnit cur = att_unit_of<FINAL>(0, vcu, G, P16w, L16w, P4w, L4w);
    bf16x8 qr[4]; float lse16 = 0.f, lse4 = 0.f;
    att_issue_K(Kg, cur, lds, wave, lane);
    att_load_q<FINAL>(Qg, L16w, L4w, cur, wave, lane, qr, lse16, lse4);
    asm volatile("s_waitcnt vmcnt(0)" : "+v"(qr[0]), "+v"(qr[1]), "+v"(qr[2]), "+v"(qr[3]), "+v"(lse16), "+v"(lse4) :: "memory");
    att_issue_V(Vg, cur, lds, wave, lane);
#pragma unroll 1
    for (int n = 0; n < N; ++n) {
        const AUnit nxt = att_unit_of<FINAL>(n + 1 < N ? n + 1 : n, vcu, G, P16w, L16w, P4w, L4w);
        const int l0 = cur.lbase + 32 * wave;
        const int kt0 = (cur.g0 - wave) > 0 ? (cur.g0 - wave) : 0;
        const int qtok = ((l0 + r32) << cur.ld) + cur.res;
        asm volatile("s_waitcnt vmcnt(6)" ::: "memory");
        ATT_BAR();
        const unsigned kb = (unsigned)(size_t)(lds + L_KIMG + wave * 4096 + r32 * 128);
        const int ksw = (r32 >> 1) & 7;
        const unsigned ka0 = kb + (((0 + hi) ^ ksw) << 4), ka1 = kb + (((2 + hi) ^ ksw) << 4), ka2 = kb + (((4 + hi) ^ ksw) << 4), ka3 = kb + (((6 + hi) ^ ksw) << 4);
        f32x16 s[5];
        bf16x8 kf[2][4];
#define KRD4(buf, kt) do { asm volatile("ds_read_b128 %0, %4 offset:%8\n\tds_read_b128 %1, %5 offset:%8\n\tds_read_b128 %2, %6 offset:%8\n\tds_read_b128 %3, %7 offset:%8" \
            : "=&v"(kf[buf][0]), "=&v"(kf[buf][1]), "=&v"(kf[buf][2]), "=&v"(kf[buf][3]) : "v"(ka0), "v"(ka1), "v"(ka2), "v"(ka3), "i"((kt) * 4096) : "memory"); } while (0)
#define KWAIT(n, buf) asm volatile("s_waitcnt lgkmcnt(" #n ")" : "+v"(kf[buf][0]), "+v"(kf[buf][1]), "+v"(kf[buf][2]), "+v"(kf[buf][3]) :: "memory")
        KRD4(0, 0);
#pragma unroll
        for (int kt = 0; kt < 5; ++kt) {
            if (kt == 0) { KRD4(1, 1); KWAIT(4, 0); } else if (kt == 1) { KRD4(0, 2); KWAIT(4, 1); } else if (kt == 2) { KRD4(1, 3); KWAIT(4, 0); } else if (kt == 3) { KRD4(0, 4); KWAIT(4, 1); } else { KWAIT(0, 0); }
            f32x16 a = {};
#pragma unroll
            for (int d0 = 0; d0 < 4; ++d0) a = __builtin_amdgcn_mfma_f32_32x32x16_bf16(kf[kt & 1][d0], qr[d0], a, 0, 0, 0);
            s[kt] = a;
        }
#undef KRD4
#undef KWAIT
#pragma unroll
        for (int kt = 0; kt < 4; ++kt) if (kt < kt0) {
#pragma unroll
            for (int rr = 0; rr < 16; ++rr) s[kt][rr] = -INFINITY; }
        ATT_BAR();
        att_issue_K(Kg, nxt, lds, wave, lane);
#pragma unroll
        for (int rr = 0; rr < 16; ++rr) { const int kk = crow(rr, hi); if (kk < r32) s[0][rr] = -INFINITY; if (kk > r32) s[4][rr] = -INFINITY; }
        float mx = s[4][0];
#pragma unroll
        for (int kt = 0; kt < 5; ++kt)
#pragma unroll
            for (int rr = 0; rr < 16; ++rr) mx = fmaxf(mx, s[kt][rr]);
        mx = fmaxf(mx, __shfl_xor(mx, 32));
        float lsum = 0.f;
#pragma unroll
        for (int kt = 0; kt < 5; ++kt)
#pragma unroll
            for (int rr = 0; rr < 16; ++rr) { const float p = __builtin_amdgcn_exp2f(s[kt][rr] - mx); s[kt][rr] = p; lsum += p; }
        lsum += __shfl_xor(lsum, 32);
        asm volatile("s_waitcnt vmcnt(6)" ::: "memory");
        ATT_BAR();
        bf16x8 qn[4]; float lse16n = 0.f, lse4n = 0.f; v4u pp16[4], pp4[4];
        att_load_q<FINAL>(Qg, L16w, L4w, nxt, wave, lane, qn, lse16n, lse4n);
        if (FINAL) {
#pragma unroll
            for (int i = 0; i < 4; ++i) { const int row = i * 8 + (lane >> 3), ch = lane & 7;
                pp16[i] = __builtin_nontemporal_load((const v4u*)(P16w + (cur.hb + l0 + row) * HD + ch * 8)); pp4[i] = __builtin_nontemporal_load((const v4u*)(P4w + (cur.hb + l0 + row) * HD + ch * 8)); }
        }
        LAS unsigned char* trb = lds + L_VIMG + wave * 4096 + (4 * hi + ((lane & 15) >> 2)) * 64 + ((lane >> 4) & 1) * 32 + (lane & 3) * 8;
        f32x16 o[2]; o[0] = f32x16{}; o[1] = f32x16{};
#pragma unroll
        for (int kt = 0; kt < 5; ++kt) {
            {
                bf16x8 pa[2];
#pragma unroll
                for (int ks = 0; ks < 2; ++ks) { v4u w; w.x = cvtpk(s[kt][8 * ks + 0], s[kt][8 * ks + 1]); w.y = cvtpk(s[kt][8 * ks + 2], s[kt][8 * ks + 3]);
                    w.z = cvtpk(s[kt][8 * ks + 4], s[kt][8 * ks + 5]); w.w = cvtpk(s[kt][8 * ks + 6], s[kt][8 * ks + 7]); pa[ks] = __builtin_bit_cast(bf16x8, w); }
#pragma unroll
                for (int d0 = 0; d0 < 2; ++d0)
#pragma unroll
                    for (int ks = 0; ks < 2; ++ks) {
                        const s16x4 lo = vtr(trb + kt * 4096 + d0 * 2048 + ks * 1024), up = vtr(trb + kt * 4096 + d0 * 2048 + ks * 1024 + 512);
                        const bf16x8 vf = (bf16x8){lo[0], lo[1], lo[2], lo[3], up[0], up[1], up[2], up[3]};
                        o[d0] = __builtin_amdgcn_mfma_f32_32x32x16_bf16(pa[ks], vf, o[d0], 0, 0, 0);
                    }
            }
        }
        ATT_BAR();
        LAS unsigned char* vbuf = lds + L_WSTG + wave * L_WSTG_STRIDE;
        LAS float* wsf = (LAS float*)(vbuf + 4096);
        LAS bf16* stg = (LAS bf16*)vbuf;
        if (!FINAL) {
            if (hi == 0) { cur.LO[(cur.rowb + qtok) * NH + cur.h] = mx + __builtin_amdgcn_logf(lsum); wsf[r32] = 1.0f / lsum; }
#pragma unroll
            for (int rr = 0; rr < 16; ++rr) {
                const int row = crow(rr, hi); const float an = wsf[row];
#pragma unroll
                for (int d0 = 0; d0 < 2; ++d0) stg[row * 64 + 32 * d0 + r32] = (bf16)cvtpk(o[d0][rr] * an, 0.f);
            }
#pragma unroll
            for (int i = 0; i < 4; ++i) { const int row = i * 8 + (lane >> 3), ch = lane & 7;
                const v4u v = *(LAS v4u*)(vbuf + row * 128 + ch * 16);
                *(v4u*)(cur.PO + (cur.hb + (((l0 + row) << cur.ld) + cur.res)) * HD + ch * 8) = v; }
        } else {
            const float mm = fmaxf(fmaxf(lse16, lse4), mx);
            const float w16 = __builtin_amdgcn_exp2f(lse16 - mm), w4 = __builtin_amdgcn_exp2f(lse4 - mm), w1 = __builtin_amdgcn_exp2f(mx - mm);
            const float inv = 1.0f / (w16 + w4 + lsum * w1);
            if (hi == 0) { wsf[r32] = w16 * inv; wsf[32 + r32] = w4 * inv; wsf[64 + r32] = w1 * inv; }
#pragma unroll
            for (int rr = 0; rr < 16; ++rr) {
                const int row = crow(rr, hi); const float a1 = wsf[64 + row];
#pragma unroll
                for (int d0 = 0; d0 < 2; ++d0) stg[row * 64 + 32 * d0 + r32] = (bf16)cvtpk(o[d0][rr] * a1, 0.f);
            }
#pragma unroll
            for (int i = 0; i < 4; ++i) { const int row = i * 8 + (lane >> 3), ch = lane & 7;
                const v4u v = *(LAS v4u*)(vbuf + row * 128 + ch * 16); const float a16 = wsf[row], a4 = wsf[32 + row];
                const v4u x = pp16[i], y = pp4[i]; v4u r;
#pragma unroll
                for (int k = 0; k < 4; ++k) {
                    const float lo = __builtin_bit_cast(float, v[k] << 16) + __builtin_bit_cast(float, x[k] << 16) * a16 + __builtin_bit_cast(float, y[k] << 16) * a4;
                    const float up = __builtin_bit_cast(float, v[k] & 0xffff0000u) + __builtin_bit_cast(float, x[k] & 0xffff0000u) * a16 + __builtin_bit_cast(float, y[k] & 0xffff0000u) * a4;
                    r[k] = cvtpk(lo, up); }
                *(v4u*)(MC + (cur.rowb + l0 + row) * DM + PW + cur.h * HD + ch * 8) = r; }
        }
#pragma unroll
        for (int d0 = 0; d0 < 4; ++d0) qr[d0] = qn[d0];
        lse16 = lse16n; lse4 = lse4n;
        asm volatile("s_waitcnt vmcnt(0)" : "+v"(qr[0]), "+v"(qr[1]), "+v"(qr[2]), "+v"(qr[3]), "+v"(lse16), "+v"(lse4) :: "memory");
        att_issue_V(Vg, nxt, lds, wave, lane);
        cur = nxt;
    }
    asm volatile("s_waitcnt vmcnt(0)" ::: "memory");
    __syncthreads();
}

__device__ __forceinline__ f32x4 bf4(v2u w) { return (f32x4){__builtin_bit_cast(float, w.x << 16), __builtin_bit_cast(float, w.x & 0xffff0000u), __builtin_bit_cast(float, w.y << 16), __builtin_bit_cast(float, w.y & 0xffff0000u)}; }
__device__ __forceinline__ float ss4(f32x4 v) { return (v.x * v.x + v.y * v.y) + (v.z * v.z + v.w * v.w); }
#define NT_ST(p, v) __builtin_nontemporal_store((v), (p))
#define NT_LD(p) __builtin_nontemporal_load((p))
template <int NR>
__device__ __forceinline__ void row_mid(const float* __restrict__ rms0, bf16* mix, const float* __restrict__ g0, const float* __restrict__ g1, const float* __restrict__ g2, bf16* H, int m0, int lane) {
    f32x4 mv[NR][4], xv[NR][4]; float r0[NR];
#pragma unroll
    for (int r = 0; r < NR; ++r) { r0[r] = rms0[m0 + r];
#pragma unroll
        for (int j = 0; j < 4; ++j) { xv[r][j] = bf4(((const v2u*)(H + (size_t)(m0 + r) * DM) + lane)[64 * j]); mv[r][j] = bf4(__builtin_nontemporal_load((const v2u*)(mix + (size_t)(m0 + r) * DM) + lane + 64 * j)); } }
    f32x4 ga[4], gb[4], gi[4];
#pragma unroll
    for (int j = 0; j < 4; ++j) { ga[j] = ((const f32x4*)g1 + lane)[64 * j]; gb[j] = ((const f32x4*)g2 + lane)[64 * j]; const f32x4 t = ((const f32x4*)g0 + lane)[64 * j];
        gi[j] = (f32x4){1.0f / t.x, 1.0f / t.y, 1.0f / t.z, 1.0f / t.w}; }
#pragma unroll
    for (int r = 0; r < NR; ++r) {
        float s = 0.f;
#pragma unroll
        for (int j = 0; j < 4; ++j) s += ss4(mv[r][j]);
        const float rstd1 = 1.0f / sqrtf(wave_sum(s) * (1.f / DM) + EPS);
        float s2 = 0.f;
#pragma unroll
        for (int j = 0; j < 4; ++j) { xv[r][j] = xv[r][j] * r0[r] * gi[j] + mv[r][j] * rstd1 * ga[j]; s2 += ss4(xv[r][j]); }
        const float rstd2 = 1.0f / sqrtf(wave_sum(s2) * (1.f / DM) + EPS);
        unsigned long long* h8 = (unsigned long long*)(H + (size_t)(m0 + r) * DM) + lane;
        unsigned long long* x8 = (unsigned long long*)(mix + (size_t)(m0 + r) * DM) + lane;
#pragma unroll
        for (int j = 0; j < 4; ++j) { const f32x4 y = xv[r][j] * rstd2 * gb[j];
            h8[64 * j] = (unsigned long long)pk2(y.x, y.y) | ((unsigned long long)pk2(y.z, y.w) << 32);
            x8[64 * j] = (unsigned long long)pk2(xv[r][j].x, xv[r][j].y) | ((unsigned long long)pk2(xv[r][j].z, xv[r][j].w) << 32); }
    }
}
template <int NR>
__device__ __forceinline__ void row_last(const bf16* __restrict__ x1b, const bf16* __restrict__ f, const float* __restrict__ g3, float* __restrict__ out, int m0, int lane) {
    f32x4 g3v[4];
#pragma unroll
    for (int j = 0; j < 4; ++j) g3v[j] = ((const f32x4*)g3 + lane)[64 * j];
    f32x4 fv[NR][4], xv[NR][4];
#pragma unroll
    for (int r = 0; r < NR; ++r)
#pragma unroll
        for (int j = 0; j < 4; ++j) { xv[r][j] = bf4(NT_LD((const v2u*)(x1b + (size_t)(m0 + r) * DM) + lane + 64 * j)); fv[r][j] = bf4(NT_LD((const v2u*)(f + (size_t)(m0 + r) * DM) + lane + 64 * j)); }
#pragma unroll
    for (int r = 0; r < NR; ++r) {
        float sf = 0.f;
#pragma unroll
        for (int j = 0; j < 4; ++j) sf += ss4(fv[r][j]);
        const float rstd3 = 1.0f / sqrtf(wave_sum(sf) * (1.f / DM) + EPS);
        f32x4* orr = (f32x4*)(out + (size_t)(m0 + r) * DM) + lane;
#pragma unroll
        for (int j = 0; j < 4; ++j) NT_ST(orr + 64 * j, xv[r][j] + fv[r][j] * rstd3 * g3v[j]);
    }
}

__device__ __forceinline__ void phase2a(const bf16* UPb, const float* w_pool, const float* pool_scale, const bf16* Qb, const bf16* Kb, const bf16* Vb, bf16* MC,
                                        bf16* P16, float* L16, bf16* P4, float* L4, LAS unsigned char* lds, int gw, int NGW, int vcu, int G, int wave, int lane) {
    for (int it = gw; it < (M / 64) * 4; it += NGW) pool_item(UPb, w_pool, pool_scale, MC, it, lds + wave * 8192, lane);
    __syncthreads();
    attn_phase<false>(Qb, Kb, Vb, P16, L16, P4, L4, MC, lds, vcu, G, wave, lane);
}
__device__ __forceinline__ void phase2b(const bf16* Qb, const bf16* Kb, const bf16* Vb, bf16* MC, bf16* P16, float* L16, bf16* P4, float* L4,
                                        LAS unsigned char* lds, int vcu, int G, int wave, int lane) {
    attn_phase<true>(Qb, Kb, Vb, P16, L16, P4, L4, MC, lds, vcu, G, wave, lane);
}
struct Args { const float* in[12]; float* out; unsigned char* ws; int ph_lo, ph_hi; };
__global__ void __launch_bounds__(NWAVES * 64, 2) mk_fwd(Args args) {
    extern __shared__ __attribute__((aligned(16))) unsigned char lds_raw[];
    LAS unsigned char* lds = (LAS unsigned char*)lds_raw;
    cg::grid_group grid = cg::this_grid();
    const int tid = threadIdx.x, lane = tid & 63, wave = __builtin_amdgcn_readfirstlane(tid >> 6);
    const int G = gridDim.x, bx = blockIdx.x;
    const int vcu = (G % 8 == 0) ? (bx % 8) * (G / 8) + bx / 8 : bx;
    const int gw = vcu * NWAVES + wave, NGW = G * NWAVES;
    unsigned char* ws = args.ws;
    const float* x = args.in[0]; const float* ln_pre_mix = args.in[1]; const float* w_in = args.in[2]; const float* w_pool = args.in[3]; const float* pool_scale = args.in[4];
    const float* w_out = args.in[5]; const float* ln_post_mix = args.in[6]; const float* ln_pre_ffn = args.in[7]; const float* w_gate = args.in[8]; const float* w_up = args.in[9];
    const float* w_down = args.in[10]; const float* ln_post_ffn = args.in[11];
    float* out = args.out;
    bf16* Win = (bf16*)(ws + WS_WIN); bf16* Wout = (bf16*)(ws + WS_WOUT); bf16* Wgu = (bf16*)(ws + WS_WGU); bf16* Wdn = (bf16*)(ws + WS_WDN);
    bf16* H = (bf16*)(ws + WS_H); bf16* MIX = (bf16*)(ws + WS_MIX); bf16* UPb = (bf16*)(ws + WS_UP);
    bf16* Qb = (bf16*)(ws + WS_Q); bf16* Kb = (bf16*)(ws + WS_K); bf16* Vb = (bf16*)(ws + WS_V); bf16* MC = (bf16*)(ws + WS_MC); bf16* ACT = (bf16*)(ws + WS_ACT);
    bf16* P16 = (bf16*)(ws + WS_P16); bf16* P4 = (bf16*)(ws + WS_MIX); float* RMS0 = (float*)(ws + WS_RMS0); float* L16 = (float*)(ws + WS_LSE); float* L4 = (float*)(ws + WS_LSE + 2 * MiB);
    volatile LAS unsigned* MISC = (volatile LAS unsigned*)(lds + LDS_BYTES - 64);
    if (tid < 16) MISC[tid] = 0u;
    __syncthreads();
    XcdBarrier bar = xcd_barrier_post((unsigned*)ws, MISC + 8);
    bf16* FB = H;
    const int lo = args.ph_lo, hi = args.ph_hi;
#define IN(k) (lo <= (k) && (k) < hi)
#define SEAM(k) do { if (IN(k) && IN((k) + 1)) xcd_barrier(bar); } while (0)
    if (args.ph_hi > 64) grid.sync();

    if (IN(0)) { p0_prologue(x, ln_pre_mix, w_in, w_out, w_gate, w_up, w_down, ws, lds, gw, NGW, wave, lane, bx * (NWAVES * 64) + tid, G * NWAVES * 64); }
    SEAM(0);
    if (IN(1)) {
        pg8::Gemm g{H, Win, M, NPROJ, DM}; pg8::StaticOrder S; S.init(M, NPROJ, G, bx);
        pg8::EpiProj E{UPb, Qb, Kb, Vb, (const float*)(ws + WS_CS), QSCALE};
        pg8::gemm_phase<pg8::EpiProj, pg8::StaticOrder, true, true>(lds, g, S, E);
    }
    SEAM(1);
    if (IN(2)) { phase2a(UPb, w_pool, pool_scale, Qb, Kb, Vb, MC, P16, L16, P4, L4, lds, gw, NGW, vcu, G, wave, lane); xcd_barrier(bar);
                 phase2b(Qb, Kb, Vb, MC, P16, L16, P4, L4, lds, vcu, G, wave, lane); }
    SEAM(2);
    if (IN(3)) {
        pg8::Gemm g{MC, Wout, M, DM, DM}; pg8::StaticOrder S; S.init(M, DM, G, bx);
        pg8::EpiPlain E{MIX, DM};
        pg8::gemm_phase<pg8::EpiPlain, pg8::StaticOrder, true, true>(lds, g, S, E);
    }
    SEAM(3);
    if (IN(4)) { for (int m = 2 * gw; m < M; m += 2 * NGW) row_mid<2>(RMS0, MIX, ln_pre_mix, ln_post_mix, ln_pre_ffn, H, m, lane); }
    SEAM(4);
    if (IN(5)) {
        pg8::Gemm g{H, Wgu, M, NGU, DM}; pg8::StaticOrder S; S.init(M, NGU, G, bx);
        pg8::EpiSwiGLU E{ACT, DFF};
        pg8::gemm_phase<pg8::EpiSwiGLU, pg8::StaticOrder, true, true>(lds, g, S, E);
    }
    SEAM(5);
    if (IN(6)) {
        pg8::Gemm g{ACT, Wdn, M, DM, DFF}; pg8::StaticOrder S; S.init(M, DM, G, bx);
        pg8::EpiPlain E{FB, DM};
        pg8::gemm_phase<pg8::EpiPlain, pg8::StaticOrder, true, true>(lds, g, S, E);
    }
    SEAM(6);
    if (IN(7)) { for (int m = 4 * gw; m < M; m += 4 * NGW) row_last<4>(MIX, FB, ln_post_ffn, out, m, lane); }
#undef IN
#undef SEAM
}

#ifndef MK_SPLIT
#define MK_SPLIT 0
#endif
extern "C" void kernel_launch(void* const* d_in, const int* in_sizes, int n_in, void* d_out, int out_size, void* d_ws, size_t ws_size, hipStream_t stream) {
    static int grid = 0;
    if (grid == 0) {
        if (n_in != 12 || in_sizes[0] != M * DM || out_size != M * DM || ws_size < WS_END) { fprintf(stderr, "kernel_launch: unexpected shapes (n_in %d, in0 %d, out %d, ws %zu)\n", n_in, n_in > 0 ? in_sizes[0] : -1, out_size, ws_size); grid = -1; return; }
        int dev = 0, cus = 0, per_cu = 0;
        hipGetDevice(&dev); hipDeviceGetAttribute(&cus, hipDeviceAttributeMultiprocessorCount, dev);
        if (hipFuncSetAttribute((const void*)mk_fwd, hipFuncAttributeMaxDynamicSharedMemorySize, LDS_BYTES) != hipSuccess) { fprintf(stderr, "kernel_launch: hipFuncSetAttribute failed\n"); grid = -1; return; }
        if (hipOccupancyMaxActiveBlocksPerMultiprocessor(&per_cu, (const void*)mk_fwd, NWAVES * 64, LDS_BYTES) != hipSuccess || per_cu < 1) { fprintf(stderr, "kernel_launch: occupancy query says %d\n", per_cu); per_cu = 1; }
        (void)hipGetLastError();
        grid = cus * 1;
        fprintf(stderr, "kernel_launch: cus %d per_cu %d grid %d\n", cus, per_cu, grid);
    }
    if (grid < 0) return;
    if (hipMemsetAsync(d_ws, 0, 65536, stream) != hipSuccess) { fprintf(stderr, "kernel_launch: hipMemsetAsync failed\n"); return; }
    Args a{};
    for (int i = 0; i < 12; ++i) a.in[i] = (const float*)d_in[i];
    a.out = (float*)d_out; a.ws = (unsigned char*)d_ws;
#if MK_SPLIT
    for (int p = 0; p < 8; ++p) { a.ph_lo = p; a.ph_hi = p + 1; void* kargs[] = {&a};
        hipError_t e = hipLaunchCooperativeKernel((const void*)mk_fwd, dim3(grid), dim3(NWAVES * 64), kargs, LDS_BYTES, stream);
        if (e != hipSuccess) { fprintf(stderr, "cooperative launch failed: %s\n", hipGetErrorString(e)); break; } }
#else
    a.ph_lo = 0; a.ph_hi = 8; void* kargs[] = {&a};
    hipError_t e = hipLaunchCooperativeKernel((const void*)mk_fwd, dim3(grid), dim3(NWAVES * 64), kargs, LDS_BYTES, stream);
    if (e != hipSuccess) fprintf(stderr, "cooperative launch failed: %s (grid %d)\n", hipGetErrorString(e), grid);
#endif
}
```

```cpp
#include <hip/hip_runtime.h>
#include <hip/hip_cooperative_groups.h>
#include <cstdio>
#include <cstdint>
namespace cg = cooperative_groups;
namespace pg8 {
#define PG8_LAS __attribute__((address_space(3)))
typedef unsigned short bf16_t;
typedef short bf16x8 __attribute__((ext_vector_type(8)));
typedef float f32x4 __attribute__((ext_vector_type(4)));
typedef unsigned u32x4 __attribute__((ext_vector_type(4)));
constexpr int BM = 256, BK = 64, HALF = 128, HTB = HALF * BK * 2  , STAGE_BYTES = 8 * HTB, NXCD = 8, WGM = 8;

__host__ __device__ __forceinline__ int lds_byte(int r, int c) { const int st = (r >> 4) * 2 + (c >> 5), rr = r & 15, cc = c & 31, ob = rr * 64 + cc * 2; return st * 1024 + (ob ^ (((ob >> 9) & 1) << 5)); }
__host__ __device__ __forceinline__ void stage_rc(int b, int& R, int& C) { const int st = b / 1024, sb = b % 1024, swz = sb ^ (((sb >> 9) & 1) << 5); R = (st >> 1) * 16 + swz / 64; C = (st & 1) * 32 + (swz % 64) / 2; }
__host__ __device__ __forceinline__ int perm32(int rho) { const int n = rho >> 4, i = rho & 15; return 8 * (i >> 2) + 4 * n + (i & 3); }

struct Unit { int pm, pn; };
struct Gemm { const bf16_t* A; const bf16_t* Bt; int M, N, K; };

struct StaticOrder {
    int nM, nN, nwg, G, c;
    __host__ __device__ void init(int M, int N, int G_, int c_) { nM = M / BM; nN = N / BM; nwg = nM * nN; G = G_; c = c_; }
    __host__ __device__ bool next(int i, Unit& u) const {
        const long L = (long)i * G + c; if (L >= nwg) return false;
        int wgid = (int)L; { const int q = nwg / NXCD, r = nwg % NXCD, xcd = wgid % NXCD, off = wgid / NXCD; wgid = (xcd < r ? xcd * (q + 1) : r * (q + 1) + (xcd - r) * q) + off; }
        const int nig = WGM * nN, gid = wgid / nig, fm = gid * WGM, gsz = (nM - fm) < WGM ? (nM - fm) : WGM;
        u.pm = fm + ((wgid % nig) % gsz); u.pn = (wgid % nig) / gsz; return true;
    }
    __device__ __forceinline__ void a_ready(const Unit&) const {}
    __device__ __forceinline__ void done(const Unit&) const {}
};

__device__ __forceinline__ unsigned cvt_pk_bf16(float lo, float hi) { unsigned r; asm volatile("v_cvt_pk_bf16_f32 %0, %1, %2" : "=v"(r) : "v"(lo), "v"(hi)); return r; }
typedef float f32x2 __attribute__((ext_vector_type(2)));
struct EpiProj {
    static constexpr bool PERM = true, AFTER_DRAIN = false;
    bf16_t* UP; bf16_t* Q; bf16_t* Kk; bf16_t* V; const float* cs; float qscale;
    __device__ __forceinline__ void operator()(const f32x4 (&acc)[2][2][4][2], const Unit& u, int wr, int wc, int fr, int fq) const {
        const int pn = u.pn;
        bf16_t* base; int colt; bool rope = false; float sc = 1.f;
        if (pn == 0) { base = UP; colt = 0; }
        else if (pn < 4) { base = Q; colt = (pn - 1) * 256; rope = true; sc = qscale; }
        else if (pn < 7) { base = Kk; colt = (pn - 4) * 256; rope = true; }
        else { base = V; colt = (pn - 7) * 256; }
        const int row0 = u.pm * BM + wr * 64 + fr;
        const int col0 = colt + wc * 32 + 8 * fq;
        const int j = 4 * (wc & 1) + fq;
        float frq[4];
#pragma unroll
        for (int i = 0; i < 4; ++i) frq[i] = __builtin_amdgcn_exp2f(-(float)(4 * j + i) * (13.287712379549449f / 32.0f)) * 0.15915494309189535f;
#pragma unroll
        for (int ai = 0; ai < 2; ++ai)
#pragma unroll
            for (int m = 0; m < 4; ++m) {
                const int row = row0 + ai * HALF + m * 16;
                f32x4 c4 = (f32x4){1.f, 1.f, 1.f, 1.f}, s4 = (f32x4){0.f, 0.f, 0.f, 0.f};
                if (rope) {
                    const float pos = (float)(row & 8191);
#pragma unroll
                    for (int i = 0; i < 4; ++i) { float rev = pos * frq[i]; rev = rev - __builtin_floorf(rev); c4[i] = __builtin_amdgcn_cosf(rev); s4[i] = __builtin_amdgcn_sinf(rev); }
                }
#pragma unroll
                for (int bj = 0; bj < 2; ++bj) {
                    const int col = col0 + bj * HALF;
                    bf16_t* dst = (pn == 0) ? base + (size_t)row * 256 + col : base + (((size_t)(row >> 13) * 12 + (col >> 6)) * 8192 + (row & 8191)) * 64 + (col & 63);
                    const f32x4 v0 = acc[ai][bj][m][0], v1 = acc[ai][bj][m][1];
                    const f32x4 o0 = (v0 * c4 - v1 * s4) * sc, o1 = (v1 * c4 + v0 * s4) * sc;
                    u32x4 w; w.x = cvt_pk_bf16(o0[0], o0[1]); w.y = cvt_pk_bf16(o0[2], o0[3]); w.z = cvt_pk_bf16(o1[0], o1[1]); w.w = cvt_pk_bf16(o1[2], o1[3]);
                    *(u32x4*)dst = w;
                }
            }
    }
};
struct EpiPlain {
    static constexpr bool PERM = true, AFTER_DRAIN = false;
    bf16_t* O; int ldc;
    __device__ __forceinline__ void operator()(const f32x4 (&acc)[2][2][4][2], const Unit& u, int wr, int wc, int fr, int fq) const {
        const int row0 = u.pm * BM + wr * 64 + fr, col0 = u.pn * BM + wc * 32 + 8 * fq;
#pragma unroll
        for (int ai = 0; ai < 2; ++ai)
#pragma unroll
            for (int m = 0; m < 4; ++m) {
                bf16_t* rowp = O + (size_t)(row0 + ai * HALF + m * 16) * ldc + col0;
#pragma unroll
                for (int bj = 0; bj < 2; ++bj) {
                    const f32x4 v0 = acc[ai][bj][m][0], v1 = acc[ai][bj][m][1];
                    u32x4 w; w.x = cvt_pk_bf16(v0[0], v0[1]); w.y = cvt_pk_bf16(v0[2], v0[3]); w.z = cvt_pk_bf16(v1[0], v1[1]); w.w = cvt_pk_bf16(v1[2], v1[3]);
                    *(u32x4*)(rowp + bj * HALF) = w;
                }
            }
    }
};
struct EpiSwiGLU {
    static constexpr bool PERM = true, AFTER_DRAIN = false;
    bf16_t* O; int ldc;
    __device__ __forceinline__ void operator()(const f32x4 (&acc)[2][2][4][2], const Unit& u, int wr, int wc, int fr, int fq) const {
        typedef unsigned u32x2 __attribute__((ext_vector_type(2)));
        const int row0 = u.pm * BM + wr * 64 + fr, col0 = u.pn * 128 + wc * 16 + 4 * fq;
#pragma unroll
        for (int ai = 0; ai < 2; ++ai)
#pragma unroll
            for (int m = 0; m < 4; ++m) {
                bf16_t* rowp = O + (size_t)(row0 + ai * HALF + m * 16) * ldc + col0;
#pragma unroll
                for (int bj = 0; bj < 2; ++bj) {
                    const f32x4 g = acc[ai][bj][m][0], up = acc[ai][bj][m][1];
                    float a[4];
#pragma unroll
                    for (int i = 0; i < 4; ++i) { const float e = __builtin_amdgcn_exp2f(g[i] * -1.4426950408889634f); a[i] = g[i] * __builtin_amdgcn_rcpf(1.0f + e) * up[i]; }
                    u32x2 w; w.x = cvt_pk_bf16(a[0], a[1]); w.y = cvt_pk_bf16(a[2], a[3]);
                    *(u32x2*)(rowp + bj * 64) = w;
                }
            }
    }
};
template <class Epi, class Sched, bool ALIGN_EPI = false, bool SP2 = false>
__device__ __forceinline__ void gemm_phase(PG8_LAS unsigned char* lds, const Gemm g, const Sched& S, const Epi& E) {
    const int tid = threadIdx.x, wid = __builtin_amdgcn_readfirstlane(tid >> 6), lane = tid & 63, wr = wid >> 2, wc = wid & 3, fr = lane & 15, fq = lane >> 4;
    const int K = g.K, nt = K / BK;
    unsigned voffA[2], voffB[2];
#pragma unroll
    for (int i = 0; i < 2; ++i) { int R, C; stage_rc(tid * 16 + i * 8192, R, C); const int Rb = Epi::PERM ? ((R & ~31) + perm32(R & 31)) : R;
        voffA[i] = (unsigned)(R * K + C) * 2u; voffB[i] = (unsigned)(Rb * K + C) * 2u; }
    const size_t kstep = (size_t)(BK * 2);
    const size_t hstep = (size_t)HALF * K * 2;
    const size_t tstep = 2 * hstep;
    const unsigned ldsw = (unsigned)wid * 1024u;
    const int aoff = lds_byte(wr * 64 + fr, fq * 8), boff = lds_byte(wc * 32 + fr, fq * 8);
#define PG8_SA(b, h) (((b) * 2 + (h)) * HTB)
#define PG8_SB(b, h) ((4 + (b) * 2 + (h)) * HTB)
#define PG8_STAGE(bufoff, gbase, voff) do { _Pragma("unroll") for (int _i = 0; _i < 2; ++_i) \
        __builtin_amdgcn_global_load_lds((const unsigned*)((const char*)(gbase) + (voff)[_i]), (PG8_LAS unsigned*)(lds + (bufoff) + ldsw + _i * 8192), 16, 0, 0); } while (0)
#define PG8_LDA(dst, b, h) do { _Pragma("unroll") for (int m = 0; m < 4; ++m) _Pragma("unroll") for (int k = 0; k < 2; ++k) dst[m][k] = *(const PG8_LAS bf16x8*)(lds + PG8_SA(b, h) + aoff + m * 2048 + k * 1024); } while (0)
#define PG8_LDB(dst, b, h) do { _Pragma("unroll") for (int n = 0; n < 2; ++n) _Pragma("unroll") for (int k = 0; k < 2; ++k) dst[n][k] = *(const PG8_LAS bf16x8*)(lds + PG8_SB(b, h) + boff + n * 2048 + k * 1024); } while (0)
#define PG8_MMA(ai, bj, At, Bt) do { __builtin_amdgcn_s_setprio(1); _Pragma("unroll") for (int m = 0; m < 4; ++m) _Pragma("unroll") for (int n = 0; n < 2; ++n) _Pragma("unroll") for (int k = 0; k < 2; ++k) \
        acc[ai][bj][m][n] = __builtin_amdgcn_mfma_f32_16x16x32_bf16(Bt[n][k], At[m][k], acc[ai][bj][m][n], 0, 0, 0); __builtin_amdgcn_s_setprio(0); } while (0)
#define PG8_WAIT_V(n) asm volatile("s_waitcnt vmcnt(" #n ")" ::: "memory")
#define PG8_WAIT_L(n) asm volatile("s_waitcnt lgkmcnt(" #n ")" ::: "memory")
#define PG8_BAR __builtin_amdgcn_s_barrier()
#define PG8_SCHED __builtin_amdgcn_sched_barrier(0)
    Unit cur, nxt; int ui = 0;
    if (!S.next(0, cur)) return;
    f32x4 acc[2][2][4][2];
#pragma unroll
    for (int a = 0; a < 2; ++a)
#pragma unroll
        for (int b = 0; b < 2; ++b)
#pragma unroll
            for (int m = 0; m < 4; ++m)
#pragma unroll
                for (int n = 0; n < 2; ++n) acc[a][b][m][n] = (f32x4){0.f, 0.f, 0.f, 0.f};
    bf16x8 At[4][2], B0[2][2], B1[2][2];
    const char* cA = (const char*)g.A + (size_t)cur.pm * tstep; const char* cB = (const char*)g.Bt + (size_t)cur.pn * tstep;
    S.a_ready(cur);
    if constexpr (SP2) {
        PG8_STAGE(PG8_SB(0, 0), cB, voffB); PG8_STAGE(PG8_SB(0, 1), cB + hstep, voffB); PG8_STAGE(PG8_SA(0, 0), cA, voffA); PG8_STAGE(PG8_SA(0, 1), cA + hstep, voffA);
        if (wr == 1) PG8_BAR;
        PG8_WAIT_V(2); PG8_BAR;
        PG8_STAGE(PG8_SB(1, 0), cB + kstep, voffB); PG8_STAGE(PG8_SA(1, 0), cA + kstep, voffA); PG8_STAGE(PG8_SB(1, 1), cB + hstep + kstep, voffB);
        PG8_WAIT_V(6); PG8_BAR;
    } else {
        PG8_STAGE(PG8_SB(0, 0), cB, voffB); PG8_STAGE(PG8_SA(0, 0), cA, voffA); PG8_STAGE(PG8_SB(0, 1), cB + hstep, voffB); PG8_STAGE(PG8_SA(0, 1), cA + hstep, voffA);
        if (wr == 1) PG8_BAR;
        PG8_WAIT_V(4); PG8_BAR;
        PG8_STAGE(PG8_SB(1, 0), cB + kstep, voffB); PG8_STAGE(PG8_SA(1, 0), cA + kstep, voffA); PG8_STAGE(PG8_SB(1, 1), cB + hstep + kstep, voffB);
        PG8_WAIT_V(6); PG8_BAR;
    }
    for (;;) {
        const bool has_next = S.next(ui + 1, nxt);
        const char* nA = has_next ? (const char*)g.A + (size_t)nxt.pm * tstep : cA; const char* nB = has_next ? (const char*)g.Bt + (size_t)nxt.pn * tstep : cB;
        for (int t = 0; t < nt; t += 2) {
            const bool last = (t == nt - 2);
            const char* a1 = cA + (size_t)(t + 1) * kstep;
            const char* a2 = last ? nA : cA + (size_t)(t + 2) * kstep; const char* b2 = last ? nB : cB + (size_t)(t + 2) * kstep;
            const char* a3 = a2 + kstep; const char* b3 = b2 + kstep;
            if (last && has_next) S.a_ready(nxt);
            if constexpr (SP2) {
            PG8_LDB(B0, 0, 0); PG8_LDB(B1, 0, 1); PG8_SCHED; PG8_LDA(At, 0, 0); PG8_STAGE(PG8_SA(1, 1), a1 + hstep, voffA);
            PG8_WAIT_V(8); PG8_WAIT_L(0); PG8_BAR; PG8_MMA(0, 0, At, B0); PG8_MMA(0, 1, At, B1); PG8_BAR; PG8_SCHED;
            PG8_LDA(At, 0, 1); PG8_STAGE(PG8_SB(0, 0), b2, voffB); PG8_STAGE(PG8_SB(0, 1), b2 + hstep, voffB); PG8_STAGE(PG8_SA(0, 0), a2, voffA);
            PG8_WAIT_V(8); PG8_WAIT_L(0); PG8_BAR; PG8_MMA(1, 0, At, B0); PG8_MMA(1, 1, At, B1); PG8_BAR; PG8_SCHED;
            PG8_LDB(B0, 1, 0); PG8_LDB(B1, 1, 1); PG8_SCHED; PG8_LDA(At, 1, 0); PG8_STAGE(PG8_SA(0, 1), a2 + hstep, voffA);
            PG8_WAIT_V(8); PG8_WAIT_L(0); PG8_BAR; PG8_MMA(0, 0, At, B0); PG8_MMA(0, 1, At, B1); PG8_BAR; PG8_SCHED;
            PG8_LDA(At, 1, 1); PG8_STAGE(PG8_SB(1, 0), b3, voffB); PG8_STAGE(PG8_SB(1, 1), b3 + hstep, voffB); PG8_STAGE(PG8_SA(1, 0), a3, voffA);
            PG8_WAIT_V(8); PG8_WAIT_L(0); PG8_BAR; PG8_MMA(1, 0, At, B0); PG8_MMA(1, 1, At, B1); PG8_BAR; PG8_SCHED;
            } else {
            PG8_LDB(B0, 0, 0); PG8_SCHED; PG8_LDA(At, 0, 0); PG8_STAGE(PG8_SA(1, 1), a1 + hstep, voffA);
            PG8_WAIT_L(8); PG8_BAR; PG8_WAIT_L(0); PG8_MMA(0, 0, At, B0); PG8_BAR; PG8_SCHED;
            PG8_LDB(B1, 0, 1); PG8_STAGE(PG8_SB(0, 0), b2, voffB);
            PG8_BAR; PG8_WAIT_L(0); PG8_MMA(0, 1, At, B1); PG8_BAR;
            PG8_LDA(At, 0, 1); PG8_STAGE(PG8_SA(0, 0), a2, voffA);
            PG8_BAR; PG8_WAIT_L(0); PG8_MMA(1, 0, At, B0); PG8_BAR; PG8_SCHED;
            PG8_STAGE(PG8_SB(0, 1), b2 + hstep, voffB);
            PG8_WAIT_V(6); PG8_BAR; PG8_MMA(1, 1, At, B1); PG8_BAR;
            PG8_LDB(B0, 1, 0); PG8_SCHED; PG8_LDA(At, 1, 0); PG8_STAGE(PG8_SA(0, 1), a2 + hstep, voffA);
            PG8_WAIT_L(8); PG8_BAR; PG8_WAIT_L(0); PG8_MMA(0, 0, At, B0); PG8_BAR; PG8_SCHED;
            PG8_LDB(B1, 1, 1); PG8_STAGE(PG8_SB(1, 0), b3, voffB);
            PG8_BAR; PG8_WAIT_L(0); PG8_MMA(0, 1, At, B1); PG8_BAR;
            PG8_LDA(At, 1, 1); PG8_STAGE(PG8_SA(1, 0), a3, voffA);
            PG8_BAR; PG8_WAIT_L(0); PG8_MMA(1, 0, At, B0); PG8_BAR; PG8_SCHED;
            PG8_STAGE(PG8_SB(1, 1), b3 + hstep, voffB);
            PG8_WAIT_V(6); PG8_BAR; PG8_MMA(1, 1, At, B1); PG8_BAR;
            }
        }
        if constexpr (ALIGN_EPI) { if (wr == 0) PG8_BAR; }
        if constexpr (!Epi::AFTER_DRAIN) { E(acc, cur, wr, wc, fr, fq); S.done(cur); }
        if (!has_next) break;
#pragma unroll
        for (int a = 0; a < 2; ++a)
#pragma unroll
            for (int b = 0; b < 2; ++b)
#pragma unroll
                for (int m = 0; m < 4; ++m)
#pragma unroll
                    for (int n = 0; n < 2; ++n) acc[a][b][m][n] = (f32x4){0.f, 0.f, 0.f, 0.f};
        cur = nxt; cA = nA; cB = nB; ++ui;
        if constexpr (ALIGN_EPI) { if (wr == 1) PG8_BAR; }
    }
    PG8_WAIT_V(0);
    if constexpr (!ALIGN_EPI) { if (wr == 0) PG8_BAR; }
    PG8_BAR;
    if constexpr (Epi::AFTER_DRAIN) { E.fused(acc, cur, wr, wc, fr, fq, lds, wid, lane); S.done(cur); }
#undef PG8_SA
#undef PG8_SB
#undef PG8_STAGE
#undef PG8_LDA
#undef PG8_LDB
#undef PG8_MMA
#undef PG8_WAIT_V
#undef PG8_WAIT_L
#undef PG8_BAR
#undef PG8_SCHED
}
}
constexpr int NWAVES = 8;
constexpr int BATCH = 4, SEQ = 8192, DM = 1024, M = BATCH * SEQ;
constexpr int PW = 256, AW = 768, NH = 12, HD = 64, NPROJ = PW + 3 * AW;
constexpr int DFF = 2816, NGU = 2 * DFF;
constexpr float EPS = 1e-6f;
constexpr float QSCALE = 0.125f * 1.4426950408889634f;
constexpr size_t MiB = 1u << 20;
constexpr size_t WS_CS = 1 * MiB;
constexpr size_t WS_WIN = 4 * MiB;
constexpr size_t WS_WOUT = 10 * MiB;
constexpr size_t WS_WGU = 12 * MiB;
constexpr size_t WS_WDN = 24 * MiB;
constexpr size_t WS_H = 32 * MiB;
constexpr size_t WS_MIX = 96 * MiB;
constexpr size_t WS_UP = 160 * MiB;
constexpr size_t WS_Q = 176 * MiB, WS_K = 224 * MiB, WS_V = 272 * MiB;
constexpr size_t WS_MC = 320 * MiB;
constexpr size_t WS_ACT = 160 * MiB;
constexpr size_t WS_LSE = 384 * MiB;
constexpr size_t WS_P16 = 388 * MiB;
constexpr size_t WS_RMS0 = 436 * MiB;
constexpr size_t WS_END = 437 * MiB;
static_assert(WS_ACT + (size_t)M * DFF * 2 <= WS_END, "ws map");
constexpr int RING_BYTES = 131072;
constexpr int LDS_BYTES = 147456;
constexpr int L_WV = 0;
constexpr int L_WV_STRIDE = 16384 + 512;
static_assert(L_WV + NWAVES * L_WV_STRIDE <= LDS_BYTES, "attention LDS");

#define GAS __attribute__((address_space(1)))
#define LAS __attribute__((address_space(3)))
typedef unsigned short bf16;
typedef unsigned v4u __attribute__((ext_vector_type(4)));
typedef unsigned v2u __attribute__((ext_vector_type(2)));
typedef float f32x4 __attribute__((ext_vector_type(4)));
typedef float f32x16 __attribute__((ext_vector_type(16)));
typedef short bf16x8 __attribute__((ext_vector_type(8)));
typedef short s16x4 __attribute__((ext_vector_type(4)));
#define LDS_WAIT() asm volatile("s_waitcnt lgkmcnt(0)" ::: "memory")
__device__ __forceinline__ unsigned f2bf(float f) { unsigned u = __builtin_bit_cast(unsigned, f); return (u + 0x7fffu + ((u >> 16) & 1u)) >> 16; }
__device__ __forceinline__ unsigned pk2(float lo, float hi) { return f2bf(lo) | (f2bf(hi) << 16); }
__device__ __forceinline__ float bf2f(unsigned short b) { return __builtin_bit_cast(float, (unsigned)b << 16); }
__device__ __forceinline__ float wave_sum(float v) {
#pragma unroll
    for (int o = 1; o < 64; o <<= 1) v += __shfl_xor(v, o);
    return v;
}

typedef GAS unsigned gu32;
#define RLX_AGENT __ATOMIC_RELAXED, __HIP_MEMORY_SCOPE_AGENT
#define XB_TMO      128
#define XB_XCNT(j)  (256  + 64 * (j))
#define XB_XSUB(j)  (1280 + 64 * (j))
#define XB_XGEN(j)  (2304 + 64 * (j))
#define XB_TOP      3328
#define XB_TOPGEN   3392
#define XCD_BAR_WORDS 3456
#define XB_SPIN_CAP (1u << 18)

__device__ __forceinline__ unsigned xb_ld(unsigned* p)              { return __hip_atomic_load(p, __ATOMIC_RELAXED, __HIP_MEMORY_SCOPE_AGENT); }
__device__ __forceinline__ unsigned xb_add(unsigned* p, unsigned v) { return __hip_atomic_fetch_add(p, v, __ATOMIC_RELAXED, __HIP_MEMORY_SCOPE_AGENT); }
__device__ __forceinline__ unsigned xb_xcc_id() { return (unsigned)__builtin_amdgcn_s_getreg((3 << 11) | 20) & 0xFu; }
#define XB_SPIN(cond, bar) do { unsigned _sp = 0; while (cond) { __builtin_amdgcn_s_sleep(1); \
    if ((++_sp & 255u) == 0u) { if (xb_ld(&(bar)[XB_TMO])) break; if (_sp > XB_SPIN_CAP) { atomicAdd(&(bar)[XB_TMO], 1u); break; } } } } while (0)

struct XcdBarrier {
    unsigned* bar; unsigned x;
    volatile LAS unsigned* st;
};

__device__ __forceinline__ XcdBarrier xcd_barrier_post(unsigned* bar, volatile LAS unsigned* st) {
    XcdBarrier b; b.bar = bar; b.x = xb_xcc_id(); b.st = st;
    if (threadIdx.x == 0) (void)xb_add(&bar[XB_XCNT(b.x)], 1u);
    return b;
}
__device__ __forceinline__ void xcd_barrier_complete(unsigned* bar, unsigned x, unsigned& nloc, unsigned& nx) {
    const unsigned G = gridDim.x * gridDim.y * gridDim.z;
    unsigned sum, cnt, mine, sp = 0u;
    for (;;) {
        sum = 0u; cnt = 0u; mine = 0u;
#pragma unroll
        for (unsigned j = 0; j < 16; ++j) { const unsigned c = xb_ld(&bar[XB_XCNT(j)]); sum += c; cnt += (c > 0u) ? 1u : 0u; mine = (j == x) ? c : mine; }
        if (sum == G) break;
        __builtin_amdgcn_s_sleep(1);
        if ((++sp & 255u) == 0u) { if (xb_ld(&bar[XB_TMO])) break; if (sp > XB_SPIN_CAP) { atomicAdd(&bar[XB_TMO], 1u); break; } }
    }
    nloc = mine > 0u ? mine : 1u; nx = cnt > 0u ? cnt : 1u;
}

__device__ __forceinline__ void xcd_barrier(const XcdBarrier& b) {
    asm volatile("s_waitcnt vmcnt(0)" ::: "memory");
    __syncthreads();
    if (threadIdx.x == 0) {
        unsigned* bar = b.bar;
        __builtin_amdgcn_s_waitcnt(0);
        unsigned nloc = b.st[0], nx = b.st[1];
        if (nloc == 0u) { xcd_barrier_complete(bar, b.x, nloc, nx); b.st[0] = nloc; b.st[1] = nx; }
        const unsigned old = xb_add(&bar[XB_XSUB(b.x)], 1u);
        const unsigned gen = old / nloc;
        if (old + 1u == (gen + 1u) * nloc) {
            __builtin_amdgcn_fence(__ATOMIC_RELEASE, "agent");
            asm volatile("s_waitcnt vmcnt(0)" ::: "memory");
            const unsigned og = xb_add(&bar[XB_TOP], 1u);
            const unsigned tg = og / nx;
            if (og + 1u == (tg + 1u) * nx) xb_add(&bar[XB_TOPGEN], 1u);
            else XB_SPIN(xb_ld(&bar[XB_TOPGEN]) == tg, bar);
            __builtin_amdgcn_fence(__ATOMIC_ACQUIRE, "agent");
            xb_add(&bar[XB_XGEN(b.x)], 1u);
            asm volatile("s_waitcnt vmcnt(0)" ::: "memory");
        } else {
            XB_SPIN(xb_ld(&bar[XB_XGEN(b.x)]) == gen, bar);
            __builtin_amdgcn_fence(__ATOMIC_ACQUIRE, "agent");
            asm volatile("s_waitcnt vmcnt(0)" ::: "memory");
        }
    }
    __syncthreads();
}

__device__ __forceinline__ void p0_transpose_item(const float* colp, int Ns, int k0, bf16* WT, int K, int n0, LAS float* scr, int lane) {
#pragma unroll 8
    for (int i = 0; i < 32; ++i) { const int kk = 2 * i + (lane >> 5); scr[kk * 33 + (lane & 31)] = __builtin_nontemporal_load(colp + (size_t)(k0 + kk) * Ns); }
    LDS_WAIT(); asm volatile("" ::: "memory");
    const int c = lane & 7;
#pragma unroll
    for (int j = 0; j < 4; ++j) { const int n = (lane >> 3) + 8 * j; const LAS float* s = scr + (8 * c) * 33 + n;
        v4u o; o.x = pk2(s[0 * 33], s[1 * 33]); o.y = pk2(s[2 * 33], s[3 * 33]); o.z = pk2(s[4 * 33], s[5 * 33]); o.w = pk2(s[6 * 33], s[7 * 33]);
        *(v4u*)(WT + (size_t)(n0 + n) * K + k0 + 8 * c) = o; }
    LDS_WAIT(); asm volatile("" ::: "memory");
}
__device__ __forceinline__ int inproj_src_col(int n) {
    if (n < PW || n >= PW + 2 * AW) return n;
    const int base = PW + ((n - PW) & ~63), p = (n - PW) & 63;
    return base + 4 * (p >> 3) + (p & 3) + 32 * ((p >> 2) & 1);
}
template <int NR>
__device__ __forceinline__ void rms_rows_to_bf16(const float* __restrict__ x, const float* __restrict__ g, bf16* __restrict__ H, float* __restrict__ rms0, int m0, int lane) {
    f32x4 v[NR][4];
#pragma unroll
    for (int r = 0; r < NR; ++r)
#pragma unroll
        for (int j = 0; j < 4; ++j) v[r][j] = __builtin_nontemporal_load((const f32x4*)(x + (size_t)(m0 + r) * DM) + lane + 64 * j);
    f32x4 gg[4];
#pragma unroll
    for (int j = 0; j < 4; ++j) gg[j] = ((const f32x4*)g + lane)[64 * j];
#pragma unroll
    for (int r = 0; r < NR; ++r) {
        float s = 0.f;
#pragma unroll
        for (int j = 0; j < 4; ++j) s += (v[r][j].x * v[r][j].x + v[r][j].y * v[r][j].y) + (v[r][j].z * v[r][j].z + v[r][j].w * v[r][j].w);
        const float rms = sqrtf(wave_sum(s) * (1.f / DM) + EPS), rstd = 1.0f / rms;
        if (lane == 0) rms0[m0 + r] = rms;
        unsigned long long* o8 = (unsigned long long*)(H + (size_t)(m0 + r) * DM) + lane;
#pragma unroll
        for (int j = 0; j < 4; ++j) { const f32x4 y = v[r][j] * rstd * gg[j];
            o8[64 * j] = (unsigned long long)pk2(y.x, y.y) | ((unsigned long long)pk2(y.z, y.w) << 32); }
    }
}
__device__ __forceinline__ void p0_prologue(const float* x, const float* ln1, const float* w_in, const float* w_out, const float* w_gate, const float* w_up, const float* w_down,
                                            unsigned char* ws, LAS unsigned char* lds, int gw, int NGW, int wave, int lane, int gtid, int GT) {
    LAS float* scr = (LAS float*)(lds + wave * 16384);
    bf16* Win = (bf16*)(ws + WS_WIN); bf16* Wout = (bf16*)(ws + WS_WOUT); bf16* Wgu = (bf16*)(ws + WS_WGU); bf16* Wdn = (bf16*)(ws + WS_WDN);
    constexpr int I_IN = (DM / 64) * (NPROJ / 32), I_OUT = (DM / 64) * (DM / 32), I_GU = (DM / 64) * (NGU / 32), I_DN = (DFF / 64) * (DM / 32);
    constexpr int NITEMS = I_IN + I_OUT + I_GU + I_DN;
    for (int it = gw; it < NITEMS; it += NGW) {
        int r = it;
        if (r < I_IN) { const int nblk = NPROJ / 32, kb = r / nblk, nb = r % nblk; const int n = nb * 32 + (lane & 31);
            p0_transpose_item(w_in + inproj_src_col(n), NPROJ, kb * 64, Win, DM, nb * 32, scr, lane); continue; } r -= I_IN;
        if (r < I_OUT) { const int nblk = DM / 32, kb = r / nblk, nb = r % nblk; const int n = nb * 32 + (lane & 31);
            p0_transpose_item(w_out + n, DM, kb * 64, Wout, DM, nb * 32, scr, lane); continue; } r -= I_OUT;
        if (r < I_GU) { const int nblk = NGU / 32, kb = r / nblk, nb = r % nblk; const int n = nb * 32 + (lane & 31);
            const float* src = ((n >> 2) & 1) ? w_up : w_gate; const int col = 4 * (n >> 3) + (n & 3);
            p0_transpose_item(src + col, DFF, kb * 64, Wgu, DM, nb * 32, scr, lane); continue; } r -= I_GU;
        { const int nblk = DM / 32, kb = r / nblk, nb = r % nblk; const int n = nb * 32 + (lane & 31);
            p0_transpose_item(w_down + n, DM, kb * 64, Wdn, DFF, nb * 32, scr, lane); }
    }
    bf16* H = (bf16*)(ws + WS_H);
    for (int m = 4 * gw; m < M; m += 4 * NGW) rms_rows_to_bf16<4>(x, ln1, H, (float*)(ws + WS_RMS0), m, lane);
}

__device__ __forceinline__ unsigned cvtpk(float lo, float hi) { unsigned r; asm volatile("v_cvt_pk_bf16_f32 %0, %1, %2" : "=v"(r) : "v"(lo), "v"(hi)); return r; }
__device__ __forceinline__ int crow(int r, int hi) { return (r & 3) + 8 * (r >> 2) + 4 * hi; }
template <int GI>
__device__ __forceinline__ void pool_d_tile(const bf16* __restrict__ up, const float* __restrict__ wg, int T0, int pos0, LAS unsigned char* Dt, int lane, bf16x8 (&wb)[2][4]) {
    constexpr int WIN = 2 << GI;
    const int r32 = lane & 31, hi = lane >> 5;
    unsigned short ur[79];
#pragma unroll
    for (int k = 1; k < WIN; ++k) ur[15 - k] = (pos0 - k >= 0) ? up[(ptrdiff_t)(T0 - k) * PW] : (unsigned short)0;
#pragma unroll
    for (int j = 0; j < 64; ++j) ur[15 + j] = up[(size_t)(T0 + j) * PW];
    float wr[2][4][8];
#pragma unroll
    for (int nh = 0; nh < 2; ++nh)
#pragma unroll
        for (int k0 = 0; k0 < 4; ++k0) { const float* wp = wg + (size_t)(16 * k0 + 8 * hi) * 64 + 32 * nh + r32;
#pragma unroll
            for (int j = 0; j < 8; ++j) wr[nh][k0][j] = wp[64 * j]; }
    float s = 0.f;
#pragma unroll
    for (int k = 1; k < WIN; ++k) s += bf2f(ur[15 - k]);
#pragma unroll
    for (int j = 0; j < 64; ++j) {
        const int pos = pos0 + j; const float c = bf2f(ur[15 + j]);
        s += c;
        const int cnt = (pos + 1 < WIN) ? pos + 1 : WIN;
        const float d = s / (float)cnt - c;
        s -= bf2f(ur[16 + j - WIN]);
        *(LAS bf16*)(Dt + j * 128 + (((lane >> 3) ^ ((j >> 1) & 7)) * 16) + (lane & 7) * 2) = (bf16)cvtpk(d, 0.f);
    }
#pragma unroll
    for (int nh = 0; nh < 2; ++nh)
#pragma unroll
        for (int k0 = 0; k0 < 4; ++k0) { v4u w; w.x = cvtpk(wr[nh][k0][0], wr[nh][k0][1]); w.y = cvtpk(wr[nh][k0][2], wr[nh][k0][3]); w.z = cvtpk(wr[nh][k0][4], wr[nh][k0][5]); w.w = cvtpk(wr[nh][k0][6], wr[nh][k0][7]);
            wb[nh][k0] = __builtin_bit_cast(bf16x8, w); }
}
__device__ __forceinline__ void pool_item(const bf16* UPb, const float* w_pool, const float* pool_scale, bf16* MC, int item, LAS unsigned char* Dt, int lane) {
    const int g = item & 3, T0 = (item >> 2) * 64, pos0 = T0 & (SEQ - 1);
    const int r32 = lane & 31, hi = lane >> 5;
    const bf16* up = UPb + g * 64 + lane; const float* wg = w_pool + (size_t)g * 4096;
    const float ps0 = pool_scale[g * 64 + r32], ps1 = pool_scale[g * 64 + 32 + r32];
    bf16x8 wb[2][4];
    if (g == 0) pool_d_tile<0>(up, wg, T0, pos0, Dt, lane, wb);
    else if (g == 1) pool_d_tile<1>(up, wg, T0, pos0, Dt, lane, wb);
    else if (g == 2) pool_d_tile<2>(up, wg, T0, pos0, Dt, lane, wb);
    else pool_d_tile<3>(up, wg, T0, pos0, Dt, lane, wb);
    f32x16 acc[2][2];
#pragma unroll
    for (int th = 0; th < 2; ++th) { acc[th][0] = f32x16{}; acc[th][1] = f32x16{};
        const int row = 32 * th + r32;
#pragma unroll
        for (int k0 = 0; k0 < 4; ++k0) { const bf16x8 af = *(LAS bf16x8*)(Dt + row * 128 + (((2 * k0 + hi) ^ ((row >> 1) & 7)) * 16));
            acc[th][0] = __builtin_amdgcn_mfma_f32_32x32x16_bf16(af, wb[0][k0], acc[th][0], 0, 0, 0);
            acc[th][1] = __builtin_amdgcn_mfma_f32_32x32x16_bf16(af, wb[1][k0], acc[th][1], 0, 0, 0); } }
#pragma unroll
    for (int th = 0; th < 2; ++th)
#pragma unroll
        for (int rr = 0; rr < 16; ++rr) { const int row = 32 * th + crow(rr, hi);
            *(LAS bf16*)(Dt + row * 128 + r32 * 2) = (bf16)cvtpk(acc[th][0][rr] * ps0, 0.f);
            *(LAS bf16*)(Dt + row * 128 + 64 + r32 * 2) = (bf16)cvtpk(acc[th][1][rr] * ps1, 0.f); }
#pragma unroll
    for (int i = 0; i < 8; ++i) { const int row = i * 8 + (lane >> 3), ch = lane & 7;
        const v4u v = *(LAS v4u*)(Dt + row * 128 + ch * 16);
        *(v4u*)(MC + (size_t)(T0 + row) * DM + g * 64 + ch * 8) = v; }
}

typedef short v4i16_t __attribute__((ext_vector_type(4)));
__device__ __forceinline__ s16x4 vtr(LAS unsigned char* p) { return __builtin_bit_cast(s16x4, __builtin_amdgcn_ds_read_tr16_b64_v4i16((LAS v4i16_t*)p)); }
constexpr int L_KIMG = 0, L_VIMG = 49152, L_WSTG = 98304, L_WSTG_STRIDE = 4096 + 512;
static_assert(L_WSTG + NWAVES * L_WSTG_STRIDE <= LDS_BYTES - 64, "attention LDS map");
struct AUnit { size_t hb, rowb; bf16* PO; float* LO; int ld, res, lbase, g0, h; };
__device__ __forceinline__ void att_issue_K(const bf16* __restrict__ Kg, const AUnit& u, LAS unsigned char* lds, int wave, int lane) {
#pragma unroll
    for (int i = 0; i < 6; ++i) { const int p = wave + 8 * i, g = p >> 2, pc = p & 3;
        const int key = 8 * pc + (lane >> 3), c = (lane & 7) ^ ((key >> 1) & 7);
        int sidx = u.lbase - 128 + 32 * g + key; sidx = sidx < 0 ? 0 : sidx;
        const int tok = (sidx << u.ld) + u.res;
        __builtin_amdgcn_global_load_lds((const unsigned*)(Kg + (u.hb + tok) * HD + c * 8), (LAS unsigned*)(lds + L_KIMG + g * 4096 + pc * 1024), 16, 0, 0); }
}
__device__ __forceinline__ void att_issue_V(const bf16* __restrict__ Vg, const AUnit& u, LAS unsigned char* lds, int wave, int lane) {
#pragma unroll
    for (int i = 0; i < 6; ++i) { const int p = wave + 8 * i, g = p >> 2, pc = p & 3, dh = pc >> 1, kg = pc & 1;
        const int key = 16 * kg + (lane >> 2);
        int sidx = u.lbase - 128 + 32 * g + key; sidx = sidx < 0 ? 0 : sidx;
        const int tok = (sidx << u.ld) + u.res;
        __builtin_amdgcn_global_load_lds((const unsigned*)(Vg + (u.hb + tok) * HD + dh * 32 + (lane & 3) * 8), (LAS unsigned*)(lds + L_VIMG + g * 4096 + dh * 2048 + kg * 1024), 16, 0, 0); }
}
template <bool FINAL>
__device__ __forceinline__ AUnit att_unit_of(int n, int vcu, int G, bf16* P16w, float* L16w, bf16* P4w, float* L4w) {
    AUnit a;
    const int U = FINAL ? vcu + G * n : vcu + G * (n >> 1), cfg = FINAL ? 0 : (n & 1);
    const int bh = U >> 5, u = U & 31, b = bh / NH; a.h = bh % NH;
    a.hb = (size_t)bh * SEQ; a.rowb = (size_t)b * SEQ;
    int blk;
    if (FINAL) { a.ld = 0; a.res = 0; blk = u; a.PO = nullptr; a.LO = nullptr; }
    else if (cfg == 0) { a.ld = 4; a.res = u >> 1; blk = u & 1; a.PO = P16w; a.LO = L16w; }
    else { a.ld = 2; a.res = u >> 3; blk = u & 7; a.PO = P4w; a.LO = L4w; }
    a.lbase = 256 * blk; a.g0 = (blk == 0) ? 4 : 0;
    return a;
}
template <bool FINAL>
__device__ __forceinline__ void att_load_q(const bf16* __restrict__ Qg, const float* __restrict__ L16, const float* __restrict__ L4,
                                           const AUnit& u, int wave, int lane, bf16x8 (&qr)[4], float& lse16, float& lse4) {
    const int r32 = lane & 31, hi = lane >> 5, l0 = u.lbase + 32 * wave;
    const int qtok = ((l0 + r32) << u.ld) + u.res;
    const bf16* qp = Qg + (u.hb + qtok) * HD + hi * 8;
#pragma unroll
    for (int d0 = 0; d0 < 4; ++d0) qr[d0] = *(const bf16x8*)(qp + 16 * d0);
    if (FINAL) { lse16 = L16[(u.rowb + qtok) * NH + u.h]; lse4 = L4[(u.rowb + qtok) * NH + u.h]; }
}
#define ATT_BAR() do { asm volatile("s_waitcnt lgkmcnt(0)" ::: "memory"); __builtin_amdgcn_s_barrier(); asm volatile("" ::: "memory"); } while (0)
template <bool FINAL>
__device__ __forceinline__ void attn_phase(const bf16* __restrict__ Qg, const bf16* __restrict__ Kg, const bf16* __restrict__ Vg, bf16* P16w, float* L16w, bf16* P4w, float* L4w,
                                           bf16* __restrict__ MC, LAS unsigned char* lds, int vcu, int G, int wave, int lane) {
    const int r32 = lane & 31, hi = lane >> 5;
    const int NU = BATCH * NH * 32;
    if (vcu >= NU) return;
    const int nk = (NU - vcu + G - 1) / G, N = FINAL ? nk : 2 * nk;
    AUnit cur = att_unit_of<FINAL>(0, vcu, G, P16w, L16w, P4w, L4w);
    bf16x8 qr[4]; float lse16 = 0.f, lse4 = 0.f;
    att_issue_K(Kg, cur, lds, wave, lane);
    att_issue_V(Vg, cur, lds, wave, lane);
    att_load_q<FINAL>(Qg, L16w, L4w, cur, wave, lane, qr, lse16, lse4);
    asm volatile("s_waitcnt vmcnt(0)" : "+v"(qr[0]), "+v"(qr[1]), "+v"(qr[2]), "+v"(qr[3]), "+v"(lse16), "+v"(lse4) :: "memory");
#pragma unroll 1
    for (int n = 0; n < N; ++n) {
        const AUnit nxt = att_unit_of<FINAL>(n + 1 < N ? n + 1 : n, vcu, G, P16w, L16w, P4w, L4w);
        const int l0 = cur.lbase + 32 * wave;
        const int kt0 = (cur.g0 - wave) > 0 ? (cur.g0 - wave) : 0;
        const int qtok = ((l0 + r32) << cur.ld) + cur.res;
        asm volatile("s_waitcnt vmcnt(6)" ::: "memory");
        ATT_BAR();
        v4u pp16[4], pp4[4];
        if (FINAL) {
#pragma unroll
            for (int i = 0; i < 4; ++i) { const int row = i * 8 + (lane >> 3), ch = lane & 7;
                pp16[i] = __builtin_nontemporal_load((const v4u*)(P16w + (cur.hb + l0 + row) * HD + ch * 8)); pp4[i] = __builtin_nontemporal_load((const v4u*)(P4w + (cur.hb + l0 + row) * HD + ch * 8)); }
        }
        const unsigned kb = (unsigned)(size_t)(lds + L_KIMG + wave * 4096 + r32 * 128);
        const int ksw = (r32 >> 1) & 7;
        const unsigned ka0 = kb + (((0 + hi) ^ ksw) << 4), ka1 = kb + (((2 + hi) ^ ksw) << 4), ka2 = kb + (((4 + hi) ^ ksw) << 4), ka3 = kb + (((6 + hi) ^ ksw) << 4);
        f32x16 s[5];
        bf16x8 kf[2][4];
#define KRD4(buf, kt) do { asm volatile("ds_read_b128 %0, %4 offset:%8\n\tds_read_b128 %1, %5 offset:%8\n\tds_read_b128 %2, %6 offset:%8\n\tds_read_b128 %3, %7 offset:%8" \
            : "=&v"(kf[buf][0]), "=&v"(kf[buf][1]), "=&v"(kf[buf][2]), "=&v"(kf[buf][3]) : "v"(ka0), "v"(ka1), "v"(ka2), "v"(ka3), "i"((kt) * 4096) : "memory"); } while (0)
#define KWAIT(n, buf) asm volatile("s_waitcnt lgkmcnt(" #n ")" : "+v"(kf[buf][0]), "+v"(kf[buf][1]), "+v"(kf[buf][2]), "+v"(kf[buf][3]) :: "memory")
        KRD4(0, 0);
#pragma unroll
        for (int kt = 0; kt < 5; ++kt) {
            if (kt == 0) { KRD4(1, 1); KWAIT(4, 0); } else if (kt == 1) { KRD4(0, 2); KWAIT(4, 1); } else if (kt == 2) { KRD4(1, 3); KWAIT(4, 0); } else if (kt == 3) { KRD4(0, 4); KWAIT(4, 1); } else { KWAIT(0, 0); }
            f32x16 a = {};
#pragma unroll
            for (int d0 = 0; d0 < 4; ++d0) a = __builtin_amdgcn_mfma_f32_32x32x16_bf16(kf[kt & 1][d0], qr[d0], a, 0, 0, 0);
            s[kt] = a;
        }
#undef KRD4
#undef KWAIT
#pragma unroll
        for (int kt = 0; kt < 4; ++kt) if (kt < kt0) {
#pragma unroll
            for (int rr = 0; rr < 16; ++rr) s[kt][rr] = -INFINITY; }
        ATT_BAR();
        att_issue_K(Kg, nxt, lds, wave, lane);
#pragma unroll
        for (int rr = 0; rr < 16; ++rr) { const int kk = crow(rr, hi); if (kk < r32) s[0][rr] = -INFINITY; if (kk > r32) s[4][rr] = -INFINITY; }
        float mx = s[4][0];
#pragma unroll
        for (int kt = 0; kt < 5; ++kt)
#pragma unroll
            for (int rr = 0; rr < 16; ++rr) mx = fmaxf(mx, s[kt][rr]);
        mx = fmaxf(mx, __shfl_xor(mx, 32));
        float lsum = 0.f;
#pragma unroll
        for (int kt = 0; kt < 5; ++kt)
#pragma unroll
            for (int rr = 0; rr < 16; ++rr) { const float p = __builtin_amdgcn_exp2f(s[kt][rr] - mx); s[kt][rr] = p; lsum += p; }
        lsum += __shfl_xor(lsum, 32);
        asm volatile("s_waitcnt vmcnt(6)" ::: "memory");
        ATT_BAR();
        bf16x8 qn[4]; float lse16n = 0.f, lse4n = 0.f;
        att_load_q<FINAL>(Qg, L16w, L4w, nxt, wave, lane, qn, lse16n, lse4n);
        LAS unsigned char* trb = lds + L_VIMG + wave * 4096 + (4 * hi + ((lane & 15) >> 2)) * 64 + ((lane >> 4) & 1) * 32 + (lane & 3) * 8;
        f32x16 o[2]; o[0] = f32x16{}; o[1] = f32x16{};
#pragma unroll
        for (int kt = 0; kt < 5; ++kt) {
            {
                bf16x8 pa[2];
#pragma unroll
                for (int ks = 0; ks < 2; ++ks) { v4u w; w.x = cvtpk(s[kt][8 * ks + 0], s[kt][8 * ks + 1]); w.y = cvtpk(s[kt][8 * ks + 2], s[kt][8 * ks + 3]);
                    w.z = cvtpk(s[kt][8 * ks + 4], s[kt][8 * ks + 5]); w.w = cvtpk(s[kt][8 * ks + 6], s[kt][8 * ks + 7]); pa[ks] = __builtin_bit_cast(bf16x8, w); }
#pragma unroll
                for (int d0 = 0; d0 < 2; ++d0)
#pragma unroll
                    for (int ks = 0; ks < 2; ++ks) {
                        const s16x4 lo = vtr(trb + kt * 4096 + d0 * 2048 + ks * 1024), up = vtr(trb + kt * 4096 + d0 * 2048 + ks * 1024 + 512);
                        const bf16x8 vf = (bf16x8){lo[0], lo[1], lo[2], lo[3], up[0], up[1], up[2], up[3]};
                        o[d0] = __builtin_amdgcn_mfma_f32_32x32x16_bf16(pa[ks], vf, o[d0], 0, 0, 0);
                    }
            }
        }
        ATT_BAR();
        LAS unsigned char* vbuf = lds + L_WSTG + wave * L_WSTG_STRIDE;
        LAS float* wsf = (LAS float*)(vbuf + 4096);
        LAS bf16* stg = (LAS bf16*)vbuf;
        if (!FINAL) {
            if (hi == 0) { cur.LO[(cur.rowb + qtok) * NH + cur.h] = mx + __builtin_amdgcn_logf(lsum); wsf[r32] = 1.0f / lsum; }
#pragma unroll
            for (int rr = 0; rr < 16; ++rr) {
                const int row = crow(rr, hi); const float an = wsf[row];
#pragma unroll
                for (int d0 = 0; d0 < 2; ++d0) stg[row * 64 + 32 * d0 + r32] = (bf16)cvtpk(o[d0][rr] * an, 0.f);
            }
#pragma unroll
            for (int i = 0; i < 4; ++i) { const int row = i * 8 + (lane >> 3), ch = lane & 7;
                const v4u v = *(LAS v4u*)(vbuf + row * 128 + ch * 16);
                *(v4u*)(cur.PO + (cur.hb + (((l0 + row) << cur.ld) + cur.res)) * HD + ch * 8) = v; }
        } else {
            const float mm = fmaxf(fmaxf(lse16, lse4), mx);
            const float w16 = __builtin_amdgcn_exp2f(lse16 - mm), w4 = __builtin_amdgcn_exp2f(lse4 - mm), w1 = __builtin_amdgcn_exp2f(mx - mm);
            const float inv = 1.0f / (w16 + w4 + lsum * w1);
            if (hi == 0) { wsf[r32] = w16 * inv; wsf[32 + r32] = w4 * inv; wsf[64 + r32] = w1 * inv; }
#pragma unroll
            for (int rr = 0; rr < 16; ++rr) {
                const int row = crow(rr, hi); const float a1 = wsf[64 + row];
#pragma unroll
                for (int d0 = 0; d0 < 2; ++d0) stg[row * 64 + 32 * d0 + r32] = (bf16)cvtpk(o[d0][rr] * a1, 0.f);
            }
#pragma unroll
            for (int i = 0; i < 4; ++i) { const int row = i * 8 + (lane >> 3), ch = lane & 7;
                const v4u v = *(LAS v4u*)(vbuf + row * 128 + ch * 16); const float a16 = wsf[row], a4 = wsf[32 + row];
                const v4u x = pp16[i], y = pp4[i]; v4u r;
#pragma unroll
                for (int k = 0; k < 4; ++k) {
                    const float lo = __builtin_bit_cast(float, v[k] << 16) + __builtin_bit_cast(float, x[k] << 16) * a16 + __builtin_bit_cast(float, y[k] << 16) * a4;
                    const float up = __builtin_bit_cast(float, v[k] & 0xffff0000u) + __builtin_bit_cast(float, x[k] & 0xffff0000u) * a16 + __builtin_bit_cast(float, y[k] & 0xffff0000u) * a4;
                    r[k] = cvtpk(lo, up); }
                *(v4u*)(MC + (cur.rowb + l0 + row) * DM + PW + cur.h * HD + ch * 8) = r; }
        }
#pragma unroll
        for (int d0 = 0; d0 < 4; ++d0) qr[d0] = qn[d0];
        lse16 = lse16n; lse4 = lse4n;
        asm volatile("s_waitcnt vmcnt(0)" : "+v"(qr[0]), "+v"(qr[1]), "+v"(qr[2]), "+v"(qr[3]), "+v"(lse16), "+v"(lse4) :: "memory");
        att_issue_V(Vg, nxt, lds, wave, lane);
        cur = nxt;
    }
    asm volatile("s_waitcnt vmcnt(0)" ::: "memory");
    __syncthreads();
}

__device__ __forceinline__ f32x4 bf4(v2u w) { return (f32x4){__builtin_bit_cast(float, w.x << 16), __builtin_bit_cast(float, w.x & 0xffff0000u), __builtin_bit_cast(float, w.y << 16), __builtin_bit_cast(float, w.y & 0xffff0000u)}; }
__device__ __forceinline__ float ss4(f32x4 v) { return (v.x * v.x + v.y * v.y) + (v.z * v.z + v.w * v.w); }
#define NT_ST(p, v) __builtin_nontemporal_store((v), (p))
#define NT_LD(p) __builtin_nontemporal_load((p))
template <int NR>
__device__ __forceinline__ void row_mid(const float* __restrict__ rms0, bf16* mix, const float* __restrict__ g0, const float* __restrict__ g1, const float* __restrict__ g2, bf16* H, int m0, int lane) {
    f32x4 mv[NR][4], xv[NR][4]; float r0[NR];
#pragma unroll
    for (int r = 0; r < NR; ++r) { r0[r] = rms0[m0 + r];
#pragma unroll
        for (int j = 0; j < 4; ++j) { xv[r][j] = bf4(((const v2u*)(H + (size_t)(m0 + r) * DM) + lane)[64 * j]); mv[r][j] = bf4(__builtin_nontemporal_load((const v2u*)(mix + (size_t)(m0 + r) * DM) + lane + 64 * j)); } }
    f32x4 ga[4], gb[4], gi[4];
#pragma unroll
    for (int j = 0; j < 4; ++j) { ga[j] = ((const f32x4*)g1 + lane)[64 * j]; gb[j] = ((const f32x4*)g2 + lane)[64 * j]; const f32x4 t = ((const f32x4*)g0 + lane)[64 * j];
        gi[j] = (f32x4){1.0f / t.x, 1.0f / t.y, 1.0f / t.z, 1.0f / t.w}; }
#pragma unroll
    for (int r = 0; r < NR; ++r) {
        float s = 0.f;
#pragma unroll
        for (int j = 0; j < 4; ++j) s += ss4(mv[r][j]);
        const float rstd1 = 1.0f / sqrtf(wave_sum(s) * (1.f / DM) + EPS);
        float s2 = 0.f;
#pragma unroll
        for (int j = 0; j < 4; ++j) { xv[r][j] = xv[r][j] * r0[r] * gi[j] + mv[r][j] * rstd1 * ga[j]; s2 += ss4(xv[r][j]); }
        const float rstd2 = 1.0f / sqrtf(wave_sum(s2) * (1.f / DM) + EPS);
        unsigned long long* h8 = (unsigned long long*)(H + (size_t)(m0 + r) * DM) + lane;
        unsigned long long* x8 = (unsigned long long*)(mix + (size_t)(m0 + r) * DM) + lane;
#pragma unroll
        for (int j = 0; j < 4; ++j) { const f32x4 y = xv[r][j] * rstd2 * gb[j];
            h8[64 * j] = (unsigned long long)pk2(y.x, y.y) | ((unsigned long long)pk2(y.z, y.w) << 32);
            x8[64 * j] = (unsigned long long)pk2(xv[r][j].x, xv[r][j].y) | ((unsigned long long)pk2(xv[r][j].z, xv[r][j].w) << 32); }
    }
}
template <int NR>
__device__ __forceinline__ void row_last(const bf16* __restrict__ x1b, const bf16* __restrict__ f, const float* __restrict__ g3, float* __restrict__ out, int m0, int lane) {
    f32x4 g3v[4];
#pragma unroll
    for (int j = 0; j < 4; ++j) g3v[j] = ((const f32x4*)g3 + lane)[64 * j];
    f32x4 fv[NR][4], xv[NR][4];
#pragma unroll
    for (int r = 0; r < NR; ++r)
#pragma unroll
        for (int j = 0; j < 4; ++j) { xv[r][j] = bf4(NT_LD((const v2u*)(x1b + (size_t)(m0 + r) * DM) + lane + 64 * j)); fv[r][j] = bf4(NT_LD((const v2u*)(f + (size_t)(m0 + r) * DM) + lane + 64 * j)); }
#pragma unroll
    for (int r = 0; r < NR; ++r) {
        float sf = 0.f;
#pragma unroll
        for (int j = 0; j < 4; ++j) sf += ss4(fv[r][j]);
        const float rstd3 = 1.0f / sqrtf(wave_sum(sf) * (1.f / DM) + EPS);
        f32x4* orr = (f32x4*)(out + (size_t)(m0 + r) * DM) + lane;
#pragma unroll
        for (int j = 0; j < 4; ++j) NT_ST(orr + 64 * j, xv[r][j] + fv[r][j] * rstd3 * g3v[j]);
    }
}

__device__ __forceinline__ void phase2a(const bf16* UPb, const float* w_pool, const float* pool_scale, const bf16* Qb, const bf16* Kb, const bf16* Vb, bf16* MC,
                                        bf16* P16, float* L16, bf16* P4, float* L4, LAS unsigned char* lds, int gw, int NGW, int vcu, int G, int wave, int lane) {
    for (int it = gw; it < (M / 64) * 4; it += NGW) pool_item(UPb, w_pool, pool_scale, MC, it, lds + wave * 8192, lane);
    __syncthreads();
    attn_phase<false>(Qb, Kb, Vb, P16, L16, P4, L4, MC, lds, vcu, G, wave, lane);
}
__device__ __forceinline__ void phase2b(const bf16* Qb, const bf16* Kb, const bf16* Vb, bf16* MC, bf16* P16, float* L16, bf16* P4, float* L4,
                                        LAS unsigned char* lds, int vcu, int G, int wave, int lane) {
    attn_phase<true>(Qb, Kb, Vb, P16, L16, P4, L4, MC, lds, vcu, G, wave, lane);
}
struct Args { const float* in[12]; float* out; unsigned char* ws; int ph_lo, ph_hi; };
__global__ void __launch_bounds__(NWAVES * 64, 2) mk_fwd(Args args) {
    extern __shared__ __attribute__((aligned(16))) unsigned char lds_raw[];
    LAS unsigned char* lds = (LAS unsigned char*)lds_raw;
    cg::grid_group grid = cg::this_grid();
    const int tid = threadIdx.x, lane = tid & 63, wave = __builtin_amdgcn_readfirstlane(tid >> 6);
    const int G = gridDim.x, bx = blockIdx.x;
    const int vcu = (G % 8 == 0) ? (bx % 8) * (G / 8) + bx / 8 : bx;
    const int gw = vcu * NWAVES + wave, NGW = G * NWAVES;
    unsigned char* ws = args.ws;
    const float* x = args.in[0]; const float* ln_pre_mix = args.in[1]; const float* w_in = args.in[2]; const float* w_pool = args.in[3]; const float* pool_scale = args.in[4];
    const float* w_out = args.in[5]; const float* ln_post_mix = args.in[6]; const float* ln_pre_ffn = args.in[7]; const float* w_gate = args.in[8]; const float* w_up = args.in[9];
    const float* w_down = args.in[10]; const float* ln_post_ffn = args.in[11];
    float* out = args.out;
    bf16* Win = (bf16*)(ws + WS_WIN); bf16* Wout = (bf16*)(ws + WS_WOUT); bf16* Wgu = (bf16*)(ws + WS_WGU); bf16* Wdn = (bf16*)(ws + WS_WDN);
    bf16* H = (bf16*)(ws + WS_H); bf16* MIX = (bf16*)(ws + WS_MIX); bf16* UPb = (bf16*)(ws + WS_UP);
    bf16* Qb = (bf16*)(ws + WS_Q); bf16* Kb = (bf16*)(ws + WS_K); bf16* Vb = (bf16*)(ws + WS_V); bf16* MC = (bf16*)(ws + WS_MC); bf16* ACT = (bf16*)(ws + WS_ACT);
    bf16* P16 = (bf16*)(ws + WS_P16); bf16* P4 = (bf16*)(ws + WS_MIX); float* RMS0 = (float*)(ws + WS_RMS0); float* L16 = (float*)(ws + WS_LSE); float* L4 = (float*)(ws + WS_LSE + 2 * MiB);
    volatile LAS unsigned* MISC = (volatile LAS unsigned*)(lds + LDS_BYTES - 64);
    if (tid < 16) MISC[tid] = 0u;
    __syncthreads();
    XcdBarrier bar = xcd_barrier_post((unsigned*)ws, MISC + 8);
    bf16* FB = H;
    const int lo = args.ph_lo, hi = args.ph_hi;
#define IN(k) (lo <= (k) && (k) < hi)
#define SEAM(k) do { if (IN(k) && IN((k) + 1)) xcd_barrier(bar); } while (0)
    if (args.ph_hi > 64) grid.sync();

    if (IN(0)) { p0_prologue(x, ln_pre_mix, w_in, w_out, w_gate, w_up, w_down, ws, lds, gw, NGW, wave, lane, bx * (NWAVES * 64) + tid, G * NWAVES * 64); }
    SEAM(0);
    if (IN(1)) {
        pg8::Gemm g{H, Win, M, NPROJ, DM}; pg8::StaticOrder S; S.init(M, NPROJ, G, bx);
        pg8::EpiProj E{UPb, Qb, Kb, Vb, (const float*)(ws + WS_CS), QSCALE};
        pg8::gemm_phase<pg8::EpiProj, pg8::StaticOrder, true, true>(lds, g, S, E);
    }
    SEAM(1);
    if (IN(2)) { phase2a(UPb, w_pool, pool_scale, Qb, Kb, Vb, MC, P16, L16, P4, L4, lds, gw, NGW, vcu, G, wave, lane); xcd_barrier(bar);
                 phase2b(Qb, Kb, Vb, MC, P16, L16, P4, L4, lds, vcu, G, wave, lane); }
    SEAM(2);
    if (IN(3)) {
        pg8::Gemm g{MC, Wout, M, DM, DM}; pg8::StaticOrder S; S.init(M, DM, G, bx);
        pg8::EpiPlain E{MIX, DM};
        pg8::gemm_phase<pg8::EpiPlain, pg8::StaticOrder, true, true>(lds, g, S, E);
    }
    SEAM(3);
    if (IN(4)) { for (int m = 2 * gw; m < M; m += 2 * NGW) row_mid<2>(RMS0, MIX, ln_pre_mix, ln_post_mix, ln_pre_ffn, H, m, lane); }
    SEAM(4);
    if (IN(5)) {
        pg8::Gemm g{H, Wgu, M, NGU, DM}; pg8::StaticOrder S; S.init(M, NGU, G, bx);
        pg8::EpiSwiGLU E{ACT, DFF};
        pg8::gemm_phase<pg8::EpiSwiGLU, pg8::StaticOrder, true, true>(lds, g, S, E);
    }
    SEAM(5);
    if (IN(6)) {
        pg8::Gemm g{ACT, Wdn, M, DM, DFF}; pg8::StaticOrder S; S.init(M, DM, G, bx);
        pg8::EpiPlain E{FB, DM};
        pg8::gemm_phase<pg8::EpiPlain, pg8::StaticOrder, true, true>(lds, g, S, E);
    }
    SEAM(6);
    if (IN(7)) { for (int m = 4 * gw; m < M; m += 4 * NGW) row_last<4>(MIX, FB, ln_post_ffn, out, m, lane); }
#undef IN
#undef SEAM
}

#ifndef MK_SPLIT
#define MK_SPLIT 0
#endif
extern "C" void kernel_launch(void* const* d_in, const int* in_sizes, int n_in, void* d_out, int out_size, void* d_ws, size_t ws_size, hipStream_t stream) {
    static int grid = 0;
    if (grid == 0) {
        if (n_in != 12 || in_sizes[0] != M * DM || out_size != M * DM || ws_size < WS_END) { fprintf(stderr, "kernel_launch: unexpected shapes (n_in %d, in0 %d, out %d, ws %zu)\n", n_in, n_in > 0 ? in_sizes[0] : -1, out_size, ws_size); grid = -1; return; }
        int dev = 0, cus = 0, per_cu = 0;
        hipGetDevice(&dev); hipDeviceGetAttribute(&cus, hipDeviceAttributeMultiprocessorCount, dev);
        if (hipFuncSetAttribute((const void*)mk_fwd, hipFuncAttributeMaxDynamicSharedMemorySize, LDS_BYTES) != hipSuccess) { fprintf(stderr, "kernel_launch: hipFuncSetAttribute failed\n"); grid = -1; return; }
        if (hipOccupancyMaxActiveBlocksPerMultiprocessor(&per_cu, (const void*)mk_fwd, NWAVES * 64, LDS_BYTES) != hipSuccess || per_cu < 1) { fprintf(stderr, "kernel_launch: occupancy query says %d\n", per_cu); per_cu = 1; }
        (void)hipGetLastError();
        grid = cus * 1;
        fprintf(stderr, "kernel_launch: cus %d per_cu %d grid %d\n", cus, per_cu, grid);
    }
    if (grid < 0) return;
    if (hipMemsetAsync(d_ws, 0, 65536, stream) != hipSuccess) { fprintf(stderr, "kernel_launch: hipMemsetAsync failed\n"); return; }
    Args a{};
    for (int i = 0; i < 12; ++i) a.in[i] = (const float*)d_in[i];
    a.out = (float*)d_out; a.ws = (unsigned char*)d_ws;
#if MK_SPLIT
    for (int p = 0; p < 8; ++p) { a.ph_lo = p; a.ph_hi = p + 1; void* kargs[] = {&a};
        hipError_t e = hipLaunchCooperativeKernel((const void*)mk_fwd, dim3(grid), dim3(NWAVES * 64), kargs, LDS_BYTES, stream);
        if (e != hipSuccess) { fprintf(stderr, "cooperative launch failed: %s\n", hipGetErrorString(e)); break; } }
#else
    a.ph_lo = 0; a.ph_hi = 8; void* kargs[] = {&a};
    hipError_t e = hipLaunchCooperativeKernel((const void*)mk_fwd, dim3(grid), dim3(NWAVES * 64), kargs, LDS_BYTES, stream);
    if (e != hipSuccess) fprintf(stderr, "cooperative launch failed: %s (grid %d)\n", hipGetErrorString(e), grid);
#endif
}
```

```cpp
#include <hip/hip_runtime.h>
#include <hip/hip_cooperative_groups.h>
#include <cstdio>
#include <cstdint>
namespace cg = cooperative_groups;
namespace pg8 {
#define PG8_LAS __attribute__((address_space(3)))
typedef unsigned short bf16_t;
typedef short bf16x8 __attribute__((ext_vector_type(8)));
typedef float f32x4 __attribute__((ext_vector_type(4)));
typedef unsigned u32x4 __attribute__((ext_vector_type(4)));
constexpr int BM = 256, BK = 64, HALF = 128, HTB = HALF * BK * 2  , STAGE_BYTES = 8 * HTB, NXCD = 8, WGM = 8;

__host__ __device__ __forceinline__ int lds_byte(int r, int c) { const int st = (r >> 4) * 2 + (c >> 5), rr = r & 15, cc = c & 31, ob = rr * 64 + cc * 2; return st * 1024 + (ob ^ (((ob >> 9) & 1) << 5)); }
__host__ __device__ __forceinline__ void stage_rc(int b, int& R, int& C) { const int st = b / 1024, sb = b % 1024, swz = sb ^ (((sb >> 9) & 1) << 5); R = (st >> 1) * 16 + swz / 64; C = (st & 1) * 32 + (swz % 64) / 2; }
__host__ __device__ __forceinline__ int perm32(int rho) { const int n = rho >> 4, i = rho & 15; return 8 * (i >> 2) + 4 * n + (i & 3); }

struct Unit { int pm, pn; };
struct Gemm { const bf16_t* A; const bf16_t* Bt; int M, N, K; };

struct StaticOrder {
    int nM, nN, nwg, G, c;
    __host__ __device__ void init(int M, int N, int G_, int c_) { nM = M / BM; nN = N / BM; nwg = nM * nN; G = G_; c = c_; }
    __host__ __device__ bool next(int i, Unit& u) const {
        const long L = (long)i * G + c; if (L >= nwg) return false;
        int wgid = (int)L; { const int q = nwg / NXCD, r = nwg % NXCD, xcd = wgid % NXCD, off = wgid / NXCD; wgid = (xcd < r ? xcd * (q + 1) : r * (q + 1) + (xcd - r) * q) + off; }
        const int nig = WGM * nN, gid = wgid / nig, fm = gid * WGM, gsz = (nM - fm) < WGM ? (nM - fm) : WGM;
        u.pm = fm + ((wgid % nig) % gsz); u.pn = (wgid % nig) / gsz; return true;
    }
    __device__ __forceinline__ void a_ready(const Unit&) const {}
    __device__ __forceinline__ void done(const Unit&) const {}
};

__device__ __forceinline__ unsigned cvt_pk_bf16(float lo, float hi) { unsigned r; asm volatile("v_cvt_pk_bf16_f32 %0, %1, %2" : "=v"(r) : "v"(lo), "v"(hi)); return r; }
typedef float f32x2 __attribute__((ext_vector_type(2)));
struct EpiProj {
    static constexpr bool PERM = true, AFTER_DRAIN = false;
    bf16_t* UP; bf16_t* Q; bf16_t* Kk; bf16_t* V; const float* cs; float qscale;
    __device__ __forceinline__ void operator()(const f32x4 (&acc)[2][2][4][2], const Unit& u, int wr, int wc, int fr, int fq) const {
        const int pn = u.pn;
        bf16_t* base; int colt; bool rope = false; float sc = 1.f;
        if (pn == 0) { base = UP; colt = 0; }
        else if (pn < 4) { base = Q; colt = (pn - 1) * 256; rope = true; sc = qscale; }
        else if (pn < 7) { base = Kk; colt = (pn - 4) * 256; rope = true; }
        else { base = V; colt = (pn - 7) * 256; }
        const int row0 = u.pm * BM + wr * 64 + fr;
        const int col0 = colt + wc * 32 + 8 * fq;
        const int j = 4 * (wc & 1) + fq;
        float frq[4];
#pragma unroll
        for (int i = 0; i < 4; ++i) frq[i] = __builtin_amdgcn_exp2f(-(float)(4 * j + i) * (13.287712379549449f / 32.0f)) * 0.15915494309189535f;
#pragma unroll
        for (int ai = 0; ai < 2; ++ai)
#pragma unroll
            for (int m = 0; m < 4; ++m) {
                const int row = row0 + ai * HALF + m * 16;
                f32x4 c4 = (f32x4){1.f, 1.f, 1.f, 1.f}, s4 = (f32x4){0.f, 0.f, 0.f, 0.f};
                if (rope) {
                    const float pos = (float)(row & 8191);
#pragma unroll
                    for (int i = 0; i < 4; ++i) { float rev = pos * frq[i]; rev = rev - __builtin_floorf(rev); c4[i] = __builtin_amdgcn_cosf(rev); s4[i] = __builtin_amdgcn_sinf(rev); }
                }
#pragma unroll
                for (int bj = 0; bj < 2; ++bj) {
                    const int col = col0 + bj * HALF;
                    bf16_t* dst = (pn == 0) ? base + (size_t)row * 256 + col : base + (((size_t)(row >> 13) * 12 + (col >> 6)) * 8192 + (row & 8191)) * 64 + (col & 63);
                    const f32x4 v0 = acc[ai][bj][m][0], v1 = acc[ai][bj][m][1];
                    const f32x4 o0 = (v0 * c4 - v1 * s4) * sc, o1 = (v1 * c4 + v0 * s4) * sc;
                    u32x4 w; w.x = cvt_pk_bf16(o0[0], o0[1]); w.y = cvt_pk_bf16(o0[2], o0[3]); w.z = cvt_pk_bf16(o1[0], o1[1]); w.w = cvt_pk_bf16(o1[2], o1[3]);
                    *(u32x4*)dst = w;
                }
            }
    }
};
struct EpiPlain {
    static constexpr bool PERM = true, AFTER_DRAIN = false;
    bf16_t* O; int ldc;
    __device__ __forceinline__ void operator()(const f32x4 (&acc)[2][2][4][2], const Unit& u, int wr, int wc, int fr, int fq) const {
        const int row0 = u.pm * BM + wr * 64 + fr, col0 = u.pn * BM + wc * 32 + 8 * fq;
#pragma unroll
        for (int ai = 0; ai < 2; ++ai)
#pragma unroll
            for (int m = 0; m < 4; ++m) {
                bf16_t* rowp = O + (size_t)(row0 + ai * HALF + m * 16) * ldc + col0;
#pragma unroll
                for (int bj = 0; bj < 2; ++bj) {
                    const f32x4 v0 = acc[ai][bj][m][0], v1 = acc[ai][bj][m][1];
                    u32x4 w; w.x = cvt_pk_bf16(v0[0], v0[1]); w.y = cvt_pk_bf16(v0[2], v0[3]); w.z = cvt_pk_bf16(v1[0], v1[1]); w.w = cvt_pk_bf16(v1[2], v1[3]);
                    *(u32x4*)(rowp + bj * HALF) = w;
                }
            }
    }
};
struct EpiSwiGLU {
    static constexpr bool PERM = true, AFTER_DRAIN = false;
    bf16_t* O; int ldc;
    __device__ __forceinline__ void operator()(const f32x4 (&acc)[2][2][4][2], const Unit& u, int wr, int wc, int fr, int fq) const {
        typedef unsigned u32x2 __attribute__((ext_vector_type(2)));
        const int row0 = u.pm * BM + wr * 64 + fr, col0 = u.pn * 128 + wc * 16 + 4 * fq;
#pragma unroll
        for (int ai = 0; ai < 2; ++ai)
#pragma unroll
            for (int m = 0; m < 4; ++m) {
                bf16_t* rowp = O + (size_t)(row0 + ai * HALF + m * 16) * ldc + col0;
#pragma unroll
                for (int bj = 0; bj < 2; ++bj) {
                    const f32x4 g = acc[ai][bj][m][0], up = acc[ai][bj][m][1];
                    float a[4];
#pragma unroll
                    for (int i = 0; i < 4; ++i) { const float e = __builtin_amdgcn_exp2f(g[i] * -1.4426950408889634f); a[i] = g[i] * __builtin_amdgcn_rcpf(1.0f + e) * up[i]; }
                    u32x2 w; w.x = cvt_pk_bf16(a[0], a[1]); w.y = cvt_pk_bf16(a[2], a[3]);
                    *(u32x2*)(rowp + bj * 64) = w;
                }
            }
    }
};
template <class Epi, class Sched, bool ALIGN_EPI = false, bool SP2 = false>
__device__ __forceinline__ void gemm_phase(PG8_LAS unsigned char* lds, const Gemm g, const Sched& S, const Epi& E) {
    const int tid = threadIdx.x, wid = __builtin_amdgcn_readfirstlane(tid >> 6), lane = tid & 63, wr = wid >> 2, wc = wid & 3, fr = lane & 15, fq = lane >> 4;
    const int K = g.K, nt = K / BK;
    unsigned voffA[2], voffB[2];
#pragma unroll
    for (int i = 0; i < 2; ++i) { int R, C; stage_rc(tid * 16 + i * 8192, R, C); const int Rb = Epi::PERM ? ((R & ~31) + perm32(R & 31)) : R;
        voffA[i] = (unsigned)(R * K + C) * 2u; voffB[i] = (unsigned)(Rb * K + C) * 2u; }
    const size_t kstep = (size_t)(BK * 2);
    const size_t hstep = (size_t)HALF * K * 2;
    const size_t tstep = 2 * hstep;
    const unsigned ldsw = (unsigned)wid * 1024u;
    const int aoff = lds_byte(wr * 64 + fr, fq * 8), boff = lds_byte(wc * 32 + fr, fq * 8);
#define PG8_SA(b, h) (((b) * 2 + (h)) * HTB)
#define PG8_SB(b, h) ((4 + (b) * 2 + (h)) * HTB)
#define PG8_STAGE(bufoff, gbase, voff) do { _Pragma("unroll") for (int _i = 0; _i < 2; ++_i) \
        __builtin_amdgcn_global_load_lds((const unsigned*)((const char*)(gbase) + (voff)[_i]), (PG8_LAS unsigned*)(lds + (bufoff) + ldsw + _i * 8192), 16, 0, 0); } while (0)
#define PG8_LDA(dst, b, h) do { _Pragma("unroll") for (int m = 0; m < 4; ++m) _Pragma("unroll") for (int k = 0; k < 2; ++k) dst[m][k] = *(const PG8_LAS bf16x8*)(lds + PG8_SA(b, h) + aoff + m * 2048 + k * 1024); } while (0)
#define PG8_LDB(dst, b, h) do { _Pragma("unroll") for (int n = 0; n < 2; ++n) _Pragma("unroll") for (int k = 0; k < 2; ++k) dst[n][k] = *(const PG8_LAS bf16x8*)(lds + PG8_SB(b, h) + boff + n * 2048 + k * 1024); } while (0)
#define PG8_MMA(ai, bj, At, Bt) do { __builtin_amdgcn_s_setprio(1); _Pragma("unroll") for (int m = 0; m < 4; ++m) _Pragma("unroll") for (int n = 0; n < 2; ++n) _Pragma("unroll") for (int k = 0; k < 2; ++k) \
        acc[ai][bj][m][n] = __builtin_amdgcn_mfma_f32_16x16x32_bf16(Bt[n][k], At[m][k], acc[ai][bj][m][n], 0, 0, 0); __builtin_amdgcn_s_setprio(0); } while (0)
#define PG8_WAIT_V(n) asm volatile("s_waitcnt vmcnt(" #n ")" ::: "memory")
#define PG8_WAIT_L(n) asm volatile("s_waitcnt lgkmcnt(" #n ")" ::: "memory")
#define PG8_BAR __builtin_amdgcn_s_barrier()
#define PG8_SCHED __builtin_amdgcn_sched_barrier(0)
    Unit cur, nxt; int ui = 0;
    if (!S.next(0, cur)) return;
    f32x4 acc[2][2][4][2];
#pragma unroll
    for (int a = 0; a < 2; ++a)
#pragma unroll
        for (int b = 0; b < 2; ++b)
#pragma unroll
            for (int m = 0; m < 4; ++m)
#pragma unroll
                for (int n = 0; n < 2; ++n) acc[a][b][m][n] = (f32x4){0.f, 0.f, 0.f, 0.f};
    bf16x8 At[4][2], B0[2][2], B1[2][2];
    const char* cA = (const char*)g.A + (size_t)cur.pm * tstep; const char* cB = (const char*)g.Bt + (size_t)cur.pn * tstep;
    S.a_ready(cur);
    if constexpr (SP2) {
        PG8_STAGE(PG8_SB(0, 0), cB, voffB); PG8_STAGE(PG8_SB(0, 1), cB + hstep, voffB); PG8_STAGE(PG8_SA(0, 0), cA, voffA); PG8_STAGE(PG8_SA(0, 1), cA + hstep, voffA);
        if (wr == 1) PG8_BAR;
        PG8_WAIT_V(2); PG8_BAR;
        PG8_STAGE(PG8_SB(1, 0), cB + kstep, voffB); PG8_STAGE(PG8_SA(1, 0), cA + kstep, voffA); PG8_STAGE(PG8_SB(1, 1), cB + hstep + kstep, voffB);
        PG8_WAIT_V(6); PG8_BAR;
    } else {
        PG8_STAGE(PG8_SB(0, 0), cB, voffB); PG8_STAGE(PG8_SA(0, 0), cA, voffA); PG8_STAGE(PG8_SB(0, 1), cB + hstep, voffB); PG8_STAGE(PG8_SA(0, 1), cA + hstep, voffA);
        if (wr == 1) PG8_BAR;
        PG8_WAIT_V(4); PG8_BAR;
        PG8_STAGE(PG8_SB(1, 0), cB + kstep, voffB); PG8_STAGE(PG8_SA(1, 0), cA + kstep, voffA); PG8_STAGE(PG8_SB(1, 1), cB + hstep + kstep, voffB);
        PG8_WAIT_V(6); PG8_BAR;
    }
    for (;;) {
        const bool has_next = S.next(ui + 1, nxt);
        const char* nA = has_next ? (const char*)g.A + (size_t)nxt.pm * tstep : cA; const char* nB = has_next ? (const char*)g.Bt + (size_t)nxt.pn * tstep : cB;
        for (int t = 0; t < nt; t += 2) {
            const bool last = (t == nt - 2);
            const char* a1 = cA + (size_t)(t + 1) * kstep;
            const char* a2 = last ? nA : cA + (size_t)(t + 2) * kstep; const char* b2 = last ? nB : cB + (size_t)(t + 2) * kstep;
            const char* a3 = a2 + kstep; const char* b3 = b2 + kstep;
            if (last && has_next) S.a_ready(nxt);
            if constexpr (SP2) {
            PG8_LDB(B0, 0, 0); PG8_LDB(B1, 0, 1); PG8_SCHED; PG8_LDA(At, 0, 0); PG8_STAGE(PG8_SA(1, 1), a1 + hstep, voffA);
            PG8_WAIT_V(8); PG8_WAIT_L(0); PG8_BAR; PG8_MMA(0, 0, At, B0); PG8_MMA(0, 1, At, B1); PG8_BAR; PG8_SCHED;
            PG8_LDA(At, 0, 1); PG8_STAGE(PG8_SB(0, 0), b2, voffB); PG8_STAGE(PG8_SB(0, 1), b2 + hstep, voffB); PG8_STAGE(PG8_SA(0, 0), a2, voffA);
            PG8_WAIT_V(8); PG8_WAIT_L(0); PG8_BAR; PG8_MMA(1, 0, At, B0); PG8_MMA(1, 1, At, B1); PG8_BAR; PG8_SCHED;
            PG8_LDB(B0, 1, 0); PG8_LDB(B1, 1, 1); PG8_SCHED; PG8_LDA(At, 1, 0); PG8_STAGE(PG8_SA(0, 1), a2 + hstep, voffA);
            PG8_WAIT_V(8); PG8_WAIT_L(0); PG8_BAR; PG8_MMA(0, 0, At, B0); PG8_MMA(0, 1, At, B1); PG8_BAR; PG8_SCHED;
            PG8_LDA(At, 1, 1); PG8_STAGE(PG8_SB(1, 0), b3, voffB); PG8_STAGE(PG8_SB(1, 1), b3 + hstep, voffB); PG8_STAGE(PG8_SA(1, 0), a3, voffA);
            PG8_WAIT_V(8); PG8_WAIT_L(0); PG8_BAR; PG8_MMA(1, 0, At, B0); PG8_MMA(1, 1, At, B1); PG8_BAR; PG8_SCHED;
            } else {
            PG8_LDB(B0, 0, 0); PG8_SCHED; PG8_LDA(At, 0, 0); PG8_STAGE(PG8_SA(1, 1), a1 + hstep, voffA);
            PG8_WAIT_L(8); PG8_BAR; PG8_WAIT_L(0); PG8_MMA(0, 0, At, B0); PG8_BAR; PG8_SCHED;
            PG8_LDB(B1, 0, 1); PG8_STAGE(PG8_SB(0, 0), b2, voffB);
            PG8_BAR; PG8_WAIT_L(0); PG8_MMA(0, 1, At, B1); PG8_BAR;
            PG8_LDA(At, 0, 1); PG8_STAGE(PG8_SA(0, 0), a2, voffA);
            PG8_BAR; PG8_WAIT_L(0); PG8_MMA(1, 0, At, B0); PG8_BAR; PG8_SCHED;
            PG8_STAGE(PG8_SB(0, 1), b2 + hstep, voffB);
            PG8_WAIT_V(6); PG8_BAR; PG8_MMA(1, 1, At, B1); PG8_BAR;
            PG8_LDB(B0, 1, 0); PG8_SCHED; PG8_LDA(At, 1, 0); PG8_STAGE(PG8_SA(0, 1), a2 + hstep, voffA);
            PG8_WAIT_L(8); PG8_BAR; PG8_WAIT_L(0); PG8_MMA(0, 0, At, B0); PG8_BAR; PG8_SCHED;
            PG8_LDB(B1, 1, 1); PG8_STAGE(PG8_SB(1, 0), b3, voffB);
            PG8_BAR; PG8_WAIT_L(0); PG8_MMA(0, 1, At, B1); PG8_BAR;
            PG8_LDA(At, 1, 1); PG8_STAGE(PG8_SA(1, 0), a3, voffA);
            PG8_BAR; PG8_WAIT_L(0); PG8_MMA(1, 0, At, B0); PG8_BAR; PG8_SCHED;
            PG8_STAGE(PG8_SB(1, 1), b3 + hstep, voffB);
            PG8_WAIT_V(6); PG8_BAR; PG8_MMA(1, 1, At, B1); PG8_BAR;
            }
        }
        if constexpr (ALIGN_EPI) { if (wr == 0) PG8_BAR; }
        if constexpr (!Epi::AFTER_DRAIN) { E(acc, cur, wr, wc, fr, fq); S.done(cur); }
        if (!has_next) break;
#pragma unroll
        for (int a = 0; a < 2; ++a)
#pragma unroll
            for (int b = 0; b < 2; ++b)
#pragma unroll
                for (int m = 0; m < 4; ++m)
#pragma unroll
                    for (int n = 0; n < 2; ++n) acc[a][b][m][n] = (f32x4){0.f, 0.f, 0.f, 0.f};
        cur = nxt; cA = nA; cB = nB; ++ui;
        if constexpr (ALIGN_EPI) { if (wr == 1) PG8_BAR; }
    }
    PG8_WAIT_V(0);
    if constexpr (!ALIGN_EPI) { if (wr == 0) PG8_BAR; }
    PG8_BAR;
    if constexpr (Epi::AFTER_DRAIN) { E.fused(acc, cur, wr, wc, fr, fq, lds, wid, lane); S.done(cur); }
#undef PG8_SA
#undef PG8_SB
#undef PG8_STAGE
#undef PG8_LDA
#undef PG8_LDB
#undef PG8_MMA
#undef PG8_WAIT_V
#undef PG8_WAIT_L
#undef PG8_BAR
#undef PG8_SCHED
}
}
constexpr int NWAVES = 8;
constexpr int BATCH = 4, SEQ = 8192, DM = 1024, M = BATCH * SEQ;
constexpr int PW = 256, AW = 768, NH = 12, HD = 64, NPROJ = PW + 3 * AW;
constexpr int DFF = 2816, NGU = 2 * DFF;
constexpr float EPS = 1e-6f;
constexpr float QSCALE = 0.125f * 1.4426950408889634f;
constexpr size_t MiB = 1u << 20;
constexpr size_t WS_CS = 1 * MiB;
constexpr size_t WS_WIN = 4 * MiB;
constexpr size_t WS_WOUT = 10 * MiB;
constexpr size_t WS_WGU = 12 * MiB;
constexpr size_t WS_WDN = 24 * MiB;
constexpr size_t WS_H = 32 * MiB;
constexpr size_t WS_MIX = 96 * MiB;
constexpr size_t WS_UP = 160 * MiB;
constexpr size_t WS_Q = 176 * MiB, WS_K = 224 * MiB, WS_V = 272 * MiB;
constexpr size_t WS_MC = 320 * MiB;
constexpr size_t WS_ACT = 160 * MiB;
constexpr size_t WS_LSE = 384 * MiB;
constexpr size_t WS_P16 = 388 * MiB;
constexpr size_t WS_RMS0 = 436 * MiB;
constexpr size_t WS_END = 437 * MiB;
static_assert(WS_ACT + (size_t)M * DFF * 2 <= WS_END, "ws map");
constexpr int RING_BYTES = 131072;
constexpr int LDS_BYTES = 147456;
constexpr int L_WV = 0;
constexpr int L_WV_STRIDE = 16384 + 512;
static_assert(L_WV + NWAVES * L_WV_STRIDE <= LDS_BYTES, "attention LDS");

#define GAS __attribute__((address_space(1)))
#define LAS __attribute__((address_space(3)))
typedef unsigned short bf16;
typedef unsigned v4u __attribute__((ext_vector_type(4)));
typedef unsigned v2u __attribute__((ext_vector_type(2)));
typedef float f32x4 __attribute__((ext_vector_type(4)));
typedef float f32x16 __attribute__((ext_vector_type(16)));
typedef short bf16x8 __attribute__((ext_vector_type(8)));
typedef short s16x4 __attribute__((ext_vector_type(4)));
#define LDS_WAIT() asm volatile("s_waitcnt lgkmcnt(0)" ::: "memory")
__device__ __forceinline__ unsigned f2bf(float f) { unsigned u = __builtin_bit_cast(unsigned, f); return (u + 0x7fffu + ((u >> 16) & 1u)) >> 16; }
__device__ __forceinline__ unsigned pk2(float lo, float hi) { return f2bf(lo) | (f2bf(hi) << 16); }
__device__ __forceinline__ float bf2f(unsigned short b) { return __builtin_bit_cast(float, (unsigned)b << 16); }
__device__ __forceinline__ float wave_sum(float v) {
#pragma unroll
    for (int o = 1; o < 64; o <<= 1) v += __shfl_xor(v, o);
    return v;
}

typedef GAS unsigned gu32;
#define RLX_AGENT __ATOMIC_RELAXED, __HIP_MEMORY_SCOPE_AGENT
#define XB_TMO      128
#define XB_XCNT(j)  (256  + 64 * (j))
#define XB_XSUB(j)  (1280 + 64 * (j))
#define XB_XGEN(j)  (2304 + 64 * (j))
#define XB_TOP      3328
#define XB_TOPGEN   3392
#define XCD_BAR_WORDS 3456
#define XB_SPIN_CAP (1u << 18)

__device__ __forceinline__ unsigned xb_ld(unsigned* p)              { return __hip_atomic_load(p, __ATOMIC_RELAXED, __HIP_MEMORY_SCOPE_AGENT); }
__device__ __forceinline__ unsigned xb_add(unsigned* p, unsigned v) { return __hip_atomic_fetch_add(p, v, __ATOMIC_RELAXED, __HIP_MEMORY_SCOPE_AGENT); }
__device__ __forceinline__ unsigned xb_xcc_id() { return (unsigned)__builtin_amdgcn_s_getreg((3 << 11) | 20) & 0xFu; }
#define XB_SPIN(cond, bar) do { unsigned _sp = 0; while (cond) { __builtin_amdgcn_s_sleep(1); \
    if ((++_sp & 255u) == 0u) { if (xb_ld(&(bar)[XB_TMO])) break; if (_sp > XB_SPIN_CAP) { atomicAdd(&(bar)[XB_TMO], 1u); break; } } } } while (0)

struct XcdBarrier {
    unsigned* bar; unsigned x;
    volatile LAS unsigned* st;
};

__device__ __forceinline__ XcdBarrier xcd_barrier_post(unsigned* bar, volatile LAS unsigned* st) {
    XcdBarrier b; b.bar = bar; b.x = xb_xcc_id(); b.st = st;
    if (threadIdx.x == 0) (void)xb_add(&bar[XB_XCNT(b.x)], 1u);
    return b;
}
__device__ __forceinline__ void xcd_barrier_complete(unsigned* bar, unsigned x, unsigned& nloc, unsigned& nx) {
    const unsigned G = gridDim.x * gridDim.y * gridDim.z;
    unsigned sum, cnt, mine, sp = 0u;
    for (;;) {
        sum = 0u; cnt = 0u; mine = 0u;
#pragma unroll
        for (unsigned j = 0; j < 16; ++j) { const unsigned c = xb_ld(&bar[XB_XCNT(j)]); sum += c; cnt += (c > 0u) ? 1u : 0u; mine = (j == x) ? c : mine; }
        if (sum == G) break;
        __builtin_amdgcn_s_sleep(1);
        if ((++sp & 255u) == 0u) { if (xb_ld(&bar[XB_TMO])) break; if (sp > XB_SPIN_CAP) { atomicAdd(&bar[XB_TMO], 1u); break; } }
    }
    nloc = mine > 0u ? mine : 1u; nx = cnt > 0u ? cnt : 1u;
}

__device__ __forceinline__ void xcd_barrier(const XcdBarrier& b) {
    asm volatile("s_waitcnt vmcnt(0)" ::: "memory");
    __syncthreads();
    if (threadIdx.x == 0) {
        unsigned* bar = b.bar;
        __builtin_amdgcn_s_waitcnt(0);
        unsigned nloc = b.st[0], nx = b.st[1];
        if (nloc == 0u) { xcd_barrier_complete(bar, b.x, nloc, nx); b.st[0] = nloc; b.st[1] = nx; }
        const unsigned old = xb_add(&bar[XB_XSUB(b.x)], 1u);
        const unsigned gen = old / nloc;
        if (old + 1u == (gen + 1u) * nloc) {
            __builtin_amdgcn_fence(__ATOMIC_RELEASE, "agent");
            asm volatile("s_waitcnt vmcnt(0)" ::: "memory");
            __builtin_amdgcn_fence(__ATOMIC_ACQUIRE, "agent");
            const unsigned og = xb_add(&bar[XB_TOP], 1u);
            const unsigned tg = og / nx;
            if (og + 1u == (tg + 1u) * nx) xb_add(&bar[XB_TOPGEN], 1u);
            else XB_SPIN(xb_ld(&bar[XB_TOPGEN]) == tg, bar);
            xb_add(&bar[XB_XGEN(b.x)], 1u);
            asm volatile("s_waitcnt vmcnt(0)" ::: "memory");
        } else {
            __builtin_amdgcn_fence(__ATOMIC_ACQUIRE, "agent");
            XB_SPIN(xb_ld(&bar[XB_XGEN(b.x)]) == gen, bar);
            asm volatile("s_waitcnt vmcnt(0)" ::: "memory");
        }
    }
    __syncthreads();
}

__device__ __forceinline__ void p0_transpose_item(const float* colp, int Ns, int k0, bf16* WT, int K, int n0, LAS float* scr, int lane) {
#pragma unroll 8
    for (int i = 0; i < 32; ++i) { const int kk = 2 * i + (lane >> 5); scr[kk * 33 + (lane & 31)] = __builtin_nontemporal_load(colp + (size_t)(k0 + kk) * Ns); }
    LDS_WAIT(); asm volatile("" ::: "memory");
    const int c = lane & 7;
#pragma unroll
    for (int j = 0; j < 4; ++j) { const int n = (lane >> 3) + 8 * j; const LAS float* s = scr + (8 * c) * 33 + n;
        v4u o; o.x = pk2(s[0 * 33], s[1 * 33]); o.y = pk2(s[2 * 33], s[3 * 33]); o.z = pk2(s[4 * 33], s[5 * 33]); o.w = pk2(s[6 * 33], s[7 * 33]);
        *(v4u*)(WT + (size_t)(n0 + n) * K + k0 + 8 * c) = o; }
    LDS_WAIT(); asm volatile("" ::: "memory");
}
__device__ __forceinline__ int inproj_src_col(int n) {
    if (n < PW || n >= PW + 2 * AW) return n;
    const int base = PW + ((n - PW) & ~63), p = (n - PW) & 63;
    return base + 4 * (p >> 3) + (p & 3) + 32 * ((p >> 2) & 1);
}
template <int NR>
__device__ __forceinline__ void rms_rows_to_bf16(const float* __restrict__ x, const float* __restrict__ g, bf16* __restrict__ H, float* __restrict__ rms0, int m0, int lane) {
    f32x4 v[NR][4];
#pragma unroll
    for (int r = 0; r < NR; ++r)
#pragma unroll
        for (int j = 0; j < 4; ++j) v[r][j] = __builtin_nontemporal_load((const f32x4*)(x + (size_t)(m0 + r) * DM) + lane + 64 * j);
    f32x4 gg[4];
#pragma unroll
    for (int j = 0; j < 4; ++j) gg[j] = ((const f32x4*)g + lane)[64 * j];
#pragma unroll
    for (int r = 0; r < NR; ++r) {
        float s = 0.f;
#pragma unroll
        for (int j = 0; j < 4; ++j) s += (v[r][j].x * v[r][j].x + v[r][j].y * v[r][j].y) + (v[r][j].z * v[r][j].z + v[r][j].w * v[r][j].w);
        const float rms = sqrtf(wave_sum(s) * (1.f / DM) + EPS), rstd = 1.0f / rms;
        if (lane == 0) rms0[m0 + r] = rms;
        unsigned long long* o8 = (unsigned long long*)(H + (size_t)(m0 + r) * DM) + lane;
#pragma unroll
        for (int j = 0; j < 4; ++j) { const f32x4 y = v[r][j] * rstd * gg[j];
            o8[64 * j] = (unsigned long long)pk2(y.x, y.y) | ((unsigned long long)pk2(y.z, y.w) << 32); }
    }
}
__device__ __forceinline__ void p0_prologue(const float* x, const float* ln1, const float* w_in, const float* w_out, const float* w_gate, const float* w_up, const float* w_down,
                                            unsigned char* ws, LAS unsigned char* lds, int gw, int NGW, int wave, int lane, int gtid, int GT) {
    LAS float* scr = (LAS float*)(lds + wave * 16384);
    bf16* Win = (bf16*)(ws + WS_WIN); bf16* Wout = (bf16*)(ws + WS_WOUT); bf16* Wgu = (bf16*)(ws + WS_WGU); bf16* Wdn = (bf16*)(ws + WS_WDN);
    constexpr int I_IN = (DM / 64) * (NPROJ / 32), I_OUT = (DM / 64) * (DM / 32), I_GU = (DM / 64) * (NGU / 32), I_DN = (DFF / 64) * (DM / 32);
    constexpr int NITEMS = I_IN + I_OUT + I_GU + I_DN;
    for (int it = gw; it < NITEMS; it += NGW) {
        int r = it;
        if (r < I_IN) { const int nblk = NPROJ / 32, kb = r / nblk, nb = r % nblk; const int n = nb * 32 + (lane & 31);
            p0_transpose_item(w_in + inproj_src_col(n), NPROJ, kb * 64, Win, DM, nb * 32, scr, lane); continue; } r -= I_IN;
        if (r < I_OUT) { const int nblk = DM / 32, kb = r / nblk, nb = r % nblk; const int n = nb * 32 + (lane & 31);
            p0_transpose_item(w_out + n, DM, kb * 64, Wout, DM, nb * 32, scr, lane); continue; } r -= I_OUT;
        if (r < I_GU) { const int nblk = NGU / 32, kb = r / nblk, nb = r % nblk; const int n = nb * 32 + (lane & 31);
            const float* src = ((n >> 2) & 1) ? w_up : w_gate; const int col = 4 * (n >> 3) + (n & 3);
            p0_transpose_item(src + col, DFF, kb * 64, Wgu, DM, nb * 32, scr, lane); continue; } r -= I_GU;
        { const int nblk = DM / 32, kb = r / nblk, nb = r % nblk; const int n = nb * 32 + (lane & 31);
            p0_transpose_item(w_down + n, DM, kb * 64, Wdn, DFF, nb * 32, scr, lane); }
    }
    bf16* H = (bf16*)(ws + WS_H);
    for (int m = 4 * gw; m < M; m += 4 * NGW) rms_rows_to_bf16<4>(x, ln1, H, (float*)(ws + WS_RMS0), m, lane);
}

__device__ __forceinline__ unsigned cvtpk(float lo, float hi) { unsigned r; asm volatile("v_cvt_pk_bf16_f32 %0, %1, %2" : "=v"(r) : "v"(lo), "v"(hi)); return r; }
__device__ __forceinline__ int crow(int r, int hi) { return (r & 3) + 8 * (r >> 2) + 4 * hi; }
template <int GI>
__device__ __forceinline__ void pool_d_tile(const bf16* __restrict__ up, const float* __restrict__ wg, int T0, int pos0, LAS unsigned char* Dt, int lane, bf16x8 (&wb)[2][4]) {
    constexpr int WIN = 2 << GI;
    const int r32 = lane & 31, hi = lane >> 5;
    unsigned short ur[79];
#pragma unroll
    for (int k = 1; k < WIN; ++k) ur[15 - k] = (pos0 - k >= 0) ? up[(ptrdiff_t)(T0 - k) * PW] : (unsigned short)0;
#pragma unroll
    for (int j = 0; j < 64; ++j) ur[15 + j] = up[(size_t)(T0 + j) * PW];
    float wr[2][4][8];
#pragma unroll
    for (int nh = 0; nh < 2; ++nh)
#pragma unroll
        for (int k0 = 0; k0 < 4; ++k0) { const float* wp = wg + (size_t)(16 * k0 + 8 * hi) * 64 + 32 * nh + r32;
#pragma unroll
            for (int j = 0; j < 8; ++j) wr[nh][k0][j] = wp[64 * j]; }
    float s = 0.f;
#pragma unroll
    for (int k = 1; k < WIN; ++k) s += bf2f(ur[15 - k]);
#pragma unroll
    for (int j = 0; j < 64; ++j) {
        const int pos = pos0 + j; const float c = bf2f(ur[15 + j]);
        s += c;
        const int cnt = (pos + 1 < WIN) ? pos + 1 : WIN;
        const float d = s / (float)cnt - c;
        s -= bf2f(ur[16 + j - WIN]);
        *(LAS bf16*)(Dt + j * 128 + (((lane >> 3) ^ ((j >> 1) & 7)) * 16) + (lane & 7) * 2) = (bf16)cvtpk(d, 0.f);
    }
#pragma unroll
    for (int nh = 0; nh < 2; ++nh)
#pragma unroll
        for (int k0 = 0; k0 < 4; ++k0) { v4u w; w.x = cvtpk(wr[nh][k0][0], wr[nh][k0][1]); w.y = cvtpk(wr[nh][k0][2], wr[nh][k0][3]); w.z = cvtpk(wr[nh][k0][4], wr[nh][k0][5]); w.w = cvtpk(wr[nh][k0][6], wr[nh][k0][7]);
            wb[nh][k0] = __builtin_bit_cast(bf16x8, w); }
}
__device__ __forceinline__ void pool_item(const bf16* UPb, const float* w_pool, const float* pool_scale, bf16* MC, int item, LAS unsigned char* Dt, int lane) {
    const int g = item & 3, T0 = (item >> 2) * 64, pos0 = T0 & (SEQ - 1);
    const int r32 = lane & 31, hi = lane >> 5;
    const bf16* up = UPb + g * 64 + lane; const float* wg = w_pool + (size_t)g * 4096;
    const float ps0 = pool_scale[g * 64 + r32], ps1 = pool_scale[g * 64 + 32 + r32];
    bf16x8 wb[2][4];
    if (g == 0) pool_d_tile<0>(up, wg, T0, pos0, Dt, lane, wb);
    else if (g == 1) pool_d_tile<1>(up, wg, T0, pos0, Dt, lane, wb);
    else if (g == 2) pool_d_tile<2>(up, wg, T0, pos0, Dt, lane, wb);
    else pool_d_tile<3>(up, wg, T0, pos0, Dt, lane, wb);
    f32x16 acc[2][2];
#pragma unroll
    for (int th = 0; th < 2; ++th) { acc[th][0] = f32x16{}; acc[th][1] = f32x16{};
        const int row = 32 * th + r32;
#pragma unroll
        for (int k0 = 0; k0 < 4; ++k0) { const bf16x8 af = *(LAS bf16x8*)(Dt + row * 128 + (((2 * k0 + hi) ^ ((row >> 1) & 7)) * 16));
            acc[th][0] = __builtin_amdgcn_mfma_f32_32x32x16_bf16(af, wb[0][k0], acc[th][0], 0, 0, 0);
            acc[th][1] = __builtin_amdgcn_mfma_f32_32x32x16_bf16(af, wb[1][k0], acc[th][1], 0, 0, 0); } }
#pragma unroll
    for (int th = 0; th < 2; ++th)
#pragma unroll
        for (int rr = 0; rr < 16; ++rr) { const int row = 32 * th + crow(rr, hi);
            *(LAS bf16*)(Dt + row * 128 + r32 * 2) = (bf16)cvtpk(acc[th][0][rr] * ps0, 0.f);
            *(LAS bf16*)(Dt + row * 128 + 64 + r32 * 2) = (bf16)cvtpk(acc[th][1][rr] * ps1, 0.f); }
#pragma unroll
    for (int i = 0; i < 8; ++i) { const int row = i * 8 + (lane >> 3), ch = lane & 7;
        const v4u v = *(LAS v4u*)(Dt + row * 128 + ch * 16);
        *(v4u*)(MC + (size_t)(T0 + row) * DM + g * 64 + ch * 8) = v; }
}

typedef short v4i16_t __attribute__((ext_vector_type(4)));
__device__ __forceinline__ s16x4 vtr(LAS unsigned char* p) { return __builtin_bit_cast(s16x4, __builtin_amdgcn_ds_read_tr16_b64_v4i16((LAS v4i16_t*)p)); }
constexpr int L_KIMG = 0, L_VIMG = 49152, L_WSTG = 98304, L_WSTG_STRIDE = 4096 + 512;
static_assert(L_WSTG + NWAVES * L_WSTG_STRIDE <= LDS_BYTES - 64, "attention LDS map");
struct AUnit { size_t hb, rowb; bf16* PO; float* LO; int ld, res, lbase, g0, h; };
__device__ __forceinline__ void att_issue_K(const bf16* __restrict__ Kg, const AUnit& u, LAS unsigned char* lds, int wave, int lane) {
#pragma unroll
    for (int i = 0; i < 6; ++i) { const int p = wave + 8 * i, g = p >> 2, pc = p & 3;
        const int key = 8 * pc + (lane >> 3), c = (lane & 7) ^ ((key >> 1) & 7);
        int sidx = u.lbase - 128 + 32 * g + key; sidx = sidx < 0 ? 0 : sidx;
        const int tok = (sidx << u.ld) + u.res;
        __builtin_amdgcn_global_load_lds((const unsigned*)(Kg + (u.hb + tok) * HD + c * 8), (LAS unsigned*)(lds + L_KIMG + g * 4096 + pc * 1024), 16, 0, 0); }
}
__device__ __forceinline__ void att_issue_V(const bf16* __restrict__ Vg, const AUnit& u, LAS unsigned char* lds, int wave, int lane) {
#pragma unroll
    for (int i = 0; i < 6; ++i) { const int p = wave + 8 * i, g = p >> 2, pc = p & 3, dh = pc >> 1, kg = pc & 1;
        const int key = 16 * kg + (lane >> 2);
        int sidx = u.lbase - 128 + 32 * g + key; sidx = sidx < 0 ? 0 : sidx;
        const int tok = (sidx << u.ld) + u.res;
        __builtin_amdgcn_global_load_lds((const unsigned*)(Vg + (u.hb + tok) * HD + dh * 32 + (lane & 3) * 8), (LAS unsigned*)(lds + L_VIMG + g * 4096 + dh * 2048 + kg * 1024), 16, 0, 0); }
}
template <bool FINAL>
__device__ __forceinline__ AUnit att_unit_of(int n, int vcu, int G, bf16* P16w, float* L16w, bf16* P4w, float* L4w) {
    AUnit a;
    const int U = FINAL ? vcu + G * n : vcu + G * (n >> 1), cfg = FINAL ? 0 : (n & 1);
    const int bh = U >> 5, u = U & 31, b = bh / NH; a.h = bh % NH;
    a.hb = (size_t)bh * SEQ; a.rowb = (size_t)b * SEQ;
    int blk;
    if (FINAL) { a.ld = 0; a.res = 0; blk = u; a.PO = nullptr; a.LO = nullptr; }
    else if (cfg == 0) { a.ld = 4; a.res = u >> 1; blk = u & 1; a.PO = P16w; a.LO = L16w; }
    else { a.ld = 2; a.res = u >> 3; blk = u & 7; a.PO = P4w; a.LO = L4w; }
    a.lbase = 256 * blk; a.g0 = (blk == 0) ? 4 : 0;
    return a;
}
template <bool FINAL>
__device__ __forceinline__ void att_load_q(const bf16* __restrict__ Qg, const float* __restrict__ L16, const float* __restrict__ L4,
                                           const AUnit& u, int wave, int lane, bf16x8 (&qr)[4], float& lse16, float& lse4) {
    const int r32 = lane & 31, hi = lane >> 5, l0 = u.lbase + 32 * wave;
    const int qtok = ((l0 + r32) << u.ld) + u.res;
    const bf16* qp = Qg + (u.hb + qtok) * HD + hi * 8;
#pragma unroll
    for (int d0 = 0; d0 < 4; ++d0) qr[d0] = *(const bf16x8*)(qp + 16 * d0);
    if (FINAL) { lse16 = L16[(u.rowb + qtok) * NH + u.h]; lse4 = L4[(u.rowb + qtok) * NH + u.h]; }
}
#define ATT_BAR() do { asm volatile("s_waitcnt lgkmcnt(0)" ::: "memory"); __builtin_amdgcn_s_barrier(); asm volatile("" ::: "memory"); } while (0)
template <bool FINAL>
__device__ __forceinline__ void attn_phase(const bf16* __restrict__ Qg, const bf16* __restrict__ Kg, const bf16* __restrict__ Vg, bf16* P16w, float* L16w, bf16* P4w, float* L4w,
                                           bf16* __restrict__ MC, LAS unsigned char* lds, int vcu, int G, int wave, int lane) {
    const int r32 = lane & 31, hi = lane >> 5;
    const int NU = BATCH * NH * 32;
    if (vcu >= NU) return;
    const int nk = (NU - vcu + G - 1) / G, N = FINAL ? nk : 2 * nk;
    AUnit cur = att_unit_of<FINAL>(0, vcu, G, P16w, L16w, P4w, L4w);
    bf16x8 qr[4]; float lse16 = 0.f, lse4 = 0.f;
    att_issue_K(Kg, cur, lds, wave, lane);
    att_issue_V(Vg, cur, lds, wave, lane);
    att_load_q<FINAL>(Qg, L16w, L4w, cur, wave, lane, qr, lse16, lse4);
    asm volatile("s_waitcnt vmcnt(0)" : "+v"(qr[0]), "+v"(qr[1]), "+v"(qr[2]), "+v"(qr[3]), "+v"(lse16), "+v"(lse4) :: "memory");
#pragma unroll 1
    for (int n = 0; n < N; ++n) {
        const AUnit nxt = att_unit_of<FINAL>(n + 1 < N ? n + 1 : n, vcu, G, P16w, L16w, P4w, L4w);
        const int l0 = cur.lbase + 32 * wave;
        const int kt0 = (cur.g0 - wave) > 0 ? (cur.g0 - wave) : 0;
        const int qtok = ((l0 + r32) << cur.ld) + cur.res;
        asm volatile("s_waitcnt vmcnt(6)" ::: "memory");
        ATT_BAR();
        v4u pp16[4], pp4[4];
        if (FINAL) {
#pragma unroll
            for (int i = 0; i < 4; ++i) { const int row = i * 8 + (lane >> 3), ch = lane & 7;
                pp16[i] = __builtin_nontemporal_load((const v4u*)(P16w + (cur.hb + l0 + row) * HD + ch * 8)); pp4[i] = __builtin_nontemporal_load((const v4u*)(P4w + (cur.hb + l0 + row) * HD + ch * 8)); }
        }
        const unsigned kb = (unsigned)(size_t)(lds + L_KIMG + wave * 4096 + r32 * 128);
        const int ksw = (r32 >> 1) & 7;
        const unsigned ka0 = kb + (((0 + hi) ^ ksw) << 4), ka1 = kb + (((2 + hi) ^ ksw) << 4), ka2 = kb + (((4 + hi) ^ ksw) << 4), ka3 = kb + (((6 + hi) ^ ksw) << 4);
        f32x16 s[5];
        bf16x8 kf[2][4];
#define KRD4(buf, kt) do { asm volatile("ds_read_b128 %0, %4 offset:%8\n\tds_read_b128 %1, %5 offset:%8\n\tds_read_b128 %2, %6 offset:%8\n\tds_read_b128 %3, %7 offset:%8" \
            : "=&v"(kf[buf][0]), "=&v"(kf[buf][1]), "=&v"(kf[buf][2]), "=&v"(kf[buf][3]) : "v"(ka0), "v"(ka1), "v"(ka2), "v"(ka3), "i"((kt) * 4096) : "memory"); } while (0)
#define KWAIT(n, buf) asm volatile("s_waitcnt lgkmcnt(" #n ")" : "+v"(kf[buf][0]), "+v"(kf[buf][1]), "+v"(kf[buf][2]), "+v"(kf[buf][3]) :: "memory")
        KRD4(0, 0);
#pragma unroll
        for (int kt = 0; kt < 5; ++kt) {
            if (kt == 0) { KRD4(1, 1); KWAIT(4, 0); } else if (kt == 1) { KRD4(0, 2); KWAIT(4, 1); } else if (kt == 2) { KRD4(1, 3); KWAIT(4, 0); } else if (kt == 3) { KRD4(0, 4); KWAIT(4, 1); } else { KWAIT(0, 0); }
            f32x16 a = {};
#pragma unroll
            for (int d0 = 0; d0 < 4; ++d0) a = __builtin_amdgcn_mfma_f32_32x32x16_bf16(kf[kt & 1][d0], qr[d0], a, 0, 0, 0);
            s[kt] = a;
        }
#undef KRD4
#undef KWAIT
#pragma unroll
        for (int kt = 0; kt < 4; ++kt) if (kt < kt0) {
#pragma unroll
            for (int rr = 0; rr < 16; ++rr) s[kt][rr] = -INFINITY; }
        ATT_BAR();
        att_issue_K(Kg, nxt, lds, wave, lane);
#pragma unroll
        for (int rr = 0; rr < 16; ++rr) { const int kk = crow(rr, hi); if (kk < r32) s[0][rr] = -INFINITY; if (kk > r32) s[4][rr] = -INFINITY; }
        float mx = s[4][0];
#pragma unroll
        for (int kt = 0; kt < 5; ++kt)
#pragma unroll
            for (int rr = 0; rr < 16; ++rr) mx = fmaxf(mx, s[kt][rr]);
        mx = fmaxf(mx, __shfl_xor(mx, 32));
        float lsum = 0.f;
#pragma unroll
        for (int kt = 0; kt < 5; ++kt)
#pragma unroll
            for (int rr = 0; rr < 16; ++rr) { const float p = __builtin_amdgcn_exp2f(s[kt][rr] - mx); s[kt][rr] = p; lsum += p; }
        lsum += __shfl_xor(lsum, 32);
        asm volatile("s_waitcnt vmcnt(6)" ::: "memory");
        ATT_BAR();
        bf16x8 qn[4]; float lse16n = 0.f, lse4n = 0.f;
        att_load_q<FINAL>(Qg, L16w, L4w, nxt, wave, lane, qn, lse16n, lse4n);
        LAS unsigned char* trb = lds + L_VIMG + wave * 4096 + (4 * hi + ((lane & 15) >> 2)) * 64 + ((lane >> 4) & 1) * 32 + (lane & 3) * 8;
        f32x16 o[2]; o[0] = f32x16{}; o[1] = f32x16{};
#pragma unroll
        for (int kt = 0; kt < 5; ++kt) {
            {
                bf16x8 pa[2];
#pragma unroll
                for (int ks = 0; ks < 2; ++ks) { v4u w; w.x = cvtpk(s[kt][8 * ks + 0], s[kt][8 * ks + 1]); w.y = cvtpk(s[kt][8 * ks + 2], s[kt][8 * ks + 3]);
                    w.z = cvtpk(s[kt][8 * ks + 4], s[kt][8 * ks + 5]); w.w = cvtpk(s[kt][8 * ks + 6], s[kt][8 * ks + 7]); pa[ks] = __builtin_bit_cast(bf16x8, w); }
#pragma unroll
                for (int d0 = 0; d0 < 2; ++d0)
#pragma unroll
                    for (int ks = 0; ks < 2; ++ks) {
                        const s16x4 lo = vtr(trb + kt * 4096 + d0 * 2048 + ks * 1024), up = vtr(trb + kt * 4096 + d0 * 2048 + ks * 1024 + 512);
                        const bf16x8 vf = (bf16x8){lo[0], lo[1], lo[2], lo[3], up[0], up[1], up[2], up[3]};
                        o[d0] = __builtin_amdgcn_mfma_f32_32x32x16_bf16(pa[ks], vf, o[d0], 0, 0, 0);
                    }
            }
        }
        ATT_BAR();
        LAS unsigned char* vbuf = lds + L_WSTG + wave * L_WSTG_STRIDE;
        LAS float* wsf = (LAS float*)(vbuf + 4096);
        LAS bf16* stg = (LAS bf16*)vbuf;
        if (!FINAL) {
            if (hi == 0) { cur.LO[(cur.rowb + qtok) * NH + cur.h] = mx + __builtin_amdgcn_logf(lsum); wsf[r32] = 1.0f / lsum; }
#pragma unroll
            for (int rr = 0; rr < 16; ++rr) {
                const int row = crow(rr, hi); const float an = wsf[row];
#pragma unroll
                for (int d0 = 0; d0 < 2; ++d0) stg[row * 64 + 32 * d0 + r32] = (bf16)cvtpk(o[d0][rr] * an, 0.f);
            }
#pragma unroll
            for (int i = 0; i < 4; ++i) { const int row = i * 8 + (lane >> 3), ch = lane & 7;
                const v4u v = *(LAS v4u*)(vbuf + row * 128 + ch * 16);
                *(v4u*)(cur.PO + (cur.hb + (((l0 + row) << cur.ld) + cur.res)) * HD + ch * 8) = v; }
        } else {
            const float mm = fmaxf(fmaxf(lse16, lse4), mx);
            const float w16 = __builtin_amdgcn_exp2f(lse16 - mm), w4 = __builtin_amdgcn_exp2f(lse4 - mm), w1 = __builtin_amdgcn_exp2f(mx - mm);
            const float inv = 1.0f / (w16 + w4 + lsum * w1);
            if (hi == 0) { wsf[r32] = w16 * inv; wsf[32 + r32] = w4 * inv; wsf[64 + r32] = w1 * inv; }
#pragma unroll
            for (int rr = 0; rr < 16; ++rr) {
                const int row = crow(rr, hi); const float a1 = wsf[64 + row];
#pragma unroll
                for (int d0 = 0; d0 < 2; ++d0) stg[row * 64 + 32 * d0 + r32] = (bf16)cvtpk(o[d0][rr] * a1, 0.f);
            }
#pragma unroll
            for (int i = 0; i < 4; ++i) { const int row = i * 8 + (lane >> 3), ch = lane & 7;
                const v4u v = *(LAS v4u*)(vbuf + row * 128 + ch * 16); const float a16 = wsf[row], a4 = wsf[32 + row];
                const v4u x = pp16[i], y = pp4[i]; v4u r;
#pragma unroll
                for (int k = 0; k < 4; ++k) {
                    const float lo = __builtin_bit_cast(float, v[k] << 16) + __builtin_bit_cast(float, x[k] << 16) * a16 + __builtin_bit_cast(float, y[k] << 16) * a4;
                    const float up = __builtin_bit_cast(float, v[k] & 0xffff0000u) + __builtin_bit_cast(float, x[k] & 0xffff0000u) * a16 + __builtin_bit_cast(float, y[k] & 0xffff0000u) * a4;
                    r[k] = cvtpk(lo, up); }
                *(v4u*)(MC + (cur.rowb + l0 + row) * DM + PW + cur.h * HD + ch * 8) = r; }
        }
#pragma unroll
        for (int d0 = 0; d0 < 4; ++d0) qr[d0] = qn[d0];
        lse16 = lse16n; lse4 = lse4n;
        asm volatile("s_waitcnt vmcnt(0)" : "+v"(qr[0]), "+v"(qr[1]), "+v"(qr[2]), "+v"(qr[3]), "+v"(lse16), "+v"(lse4) :: "memory");
        att_issue_V(Vg, nxt, lds, wave, lane);
        cur = nxt;
    }
    asm volatile("s_waitcnt vmcnt(0)" ::: "memory");
    __syncthreads();
}

__device__ __forceinline__ f32x4 bf4(v2u w) { return (f32x4){__builtin_bit_cast(float, w.x << 16), __builtin_bit_cast(float, w.x & 0xffff0000u), __builtin_bit_cast(float, w.y << 16), __builtin_bit_cast(float, w.y & 0xffff0000u)}; }
__device__ __forceinline__ float ss4(f32x4 v) { return (v.x * v.x + v.y * v.y) + (v.z * v.z + v.w * v.w); }
#define NT_ST(p, v) __builtin_nontemporal_store((v), (p))
#define NT_LD(p) __builtin_nontemporal_load((p))
template <int NR>
__device__ __forceinline__ void row_mid(const float* __restrict__ rms0, bf16* mix, const float* __restrict__ g0, const float* __restrict__ g1, const float* __restrict__ g2, bf16* H, int m0, int lane) {
    f32x4 mv[NR][4], xv[NR][4]; float r0[NR];
#pragma unroll
    for (int r = 0; r < NR; ++r) { r0[r] = rms0[m0 + r];
#pragma unroll
        for (int j = 0; j < 4; ++j) { xv[r][j] = bf4(((const v2u*)(H + (size_t)(m0 + r) * DM) + lane)[64 * j]); mv[r][j] = bf4(__builtin_nontemporal_load((const v2u*)(mix + (size_t)(m0 + r) * DM) + lane + 64 * j)); } }
    f32x4 ga[4], gb[4], gi[4];
#pragma unroll
    for (int j = 0; j < 4; ++j) { ga[j] = ((const f32x4*)g1 + lane)[64 * j]; gb[j] = ((const f32x4*)g2 + lane)[64 * j]; const f32x4 t = ((const f32x4*)g0 + lane)[64 * j];
        gi[j] = (f32x4){1.0f / t.x, 1.0f / t.y, 1.0f / t.z, 1.0f / t.w}; }
#pragma unroll
    for (int r = 0; r < NR; ++r) {
        float s = 0.f;
#pragma unroll
        for (int j = 0; j < 4; ++j) s += ss4(mv[r][j]);
        const float rstd1 = 1.0f / sqrtf(wave_sum(s) * (1.f / DM) + EPS);
        float s2 = 0.f;
#pragma unroll
        for (int j = 0; j < 4; ++j) { xv[r][j] = xv[r][j] * r0[r] * gi[j] + mv[r][j] * rstd1 * ga[j]; s2 += ss4(xv[r][j]); }
        const float rstd2 = 1.0f / sqrtf(wave_sum(s2) * (1.f / DM) + EPS);
        unsigned long long* h8 = (unsigned long long*)(H + (size_t)(m0 + r) * DM) + lane;
        unsigned long long* x8 = (unsigned long long*)(mix + (size_t)(m0 + r) * DM) + lane;
#pragma unroll
        for (int j = 0; j < 4; ++j) { const f32x4 y = xv[r][j] * rstd2 * gb[j];
            h8[64 * j] = (unsigned long long)pk2(y.x, y.y) | ((unsigned long long)pk2(y.z, y.w) << 32);
            x8[64 * j] = (unsigned long long)pk2(xv[r][j].x, xv[r][j].y) | ((unsigned long long)pk2(xv[r][j].z, xv[r][j].w) << 32); }
    }
}
template <int NR>
__device__ __forceinline__ void row_last(const bf16* __restrict__ x1b, const bf16* __restrict__ f, const float* __restrict__ g3, float* __restrict__ out, int m0, int lane) {
    f32x4 g3v[4];
#pragma unroll
    for (int j = 0; j < 4; ++j) g3v[j] = ((const f32x4*)g3 + lane)[64 * j];
    f32x4 fv[NR][4], xv[NR][4];
#pragma unroll
    for (int r = 0; r < NR; ++r)
#pragma unroll
        for (int j = 0; j < 4; ++j) { xv[r][j] = bf4(NT_LD((const v2u*)(x1b + (size_t)(m0 + r) * DM) + lane + 64 * j)); fv[r][j] = bf4(NT_LD((const v2u*)(f + (size_t)(m0 + r) * DM) + lane + 64 * j)); }
#pragma unroll
    for (int r = 0; r < NR; ++r) {
        float sf = 0.f;
#pragma unroll
        for (int j = 0; j < 4; ++j) sf += ss4(fv[r][j]);
        const float rstd3 = 1.0f / sqrtf(wave_sum(sf) * (1.f / DM) + EPS);
        f32x4* orr = (f32x4*)(out + (size_t)(m0 + r) * DM) + lane;
#pragma unroll
        for (int j = 0; j < 4; ++j) NT_ST(orr + 64 * j, xv[r][j] + fv[r][j] * rstd3 * g3v[j]);
    }
}

__device__ __forceinline__ void phase2a(const bf16* UPb, const float* w_pool, const float* pool_scale, const bf16* Qb, const bf16* Kb, const bf16* Vb, bf16* MC,
                                        bf16* P16, float* L16, bf16* P4, float* L4, LAS unsigned char* lds, int gw, int NGW, int vcu, int G, int wave, int lane) {
    for (int it = gw; it < (M / 64) * 4; it += NGW) pool_item(UPb, w_pool, pool_scale, MC, it, lds + wave * 8192, lane);
    __syncthreads();
    attn_phase<false>(Qb, Kb, Vb, P16, L16, P4, L4, MC, lds, vcu, G, wave, lane);
}
__device__ __forceinline__ void phase2b(const bf16* Qb, const bf16* Kb, const bf16* Vb, bf16* MC, bf16* P16, float* L16, bf16* P4, float* L4,
                                        LAS unsigned char* lds, int vcu, int G, int wave, int lane) {
    attn_phase<true>(Qb, Kb, Vb, P16, L16, P4, L4, MC, lds, vcu, G, wave, lane);
}
struct Args { const float* in[12]; float* out; unsigned char* ws; int ph_lo, ph_hi; };
__global__ void __launch_bounds__(NWAVES * 64, 2) mk_fwd(Args args) {
    extern __shared__ __attribute__((aligned(16))) unsigned char lds_raw[];
    LAS unsigned char* lds = (LAS unsigned char*)lds_raw;
    cg::grid_group grid = cg::this_grid();
    const int tid = threadIdx.x, lane = tid & 63, wave = __builtin_amdgcn_readfirstlane(tid >> 6);
    const int G = gridDim.x, bx = blockIdx.x;
    const int vcu = (G % 8 == 0) ? (bx % 8) * (G / 8) + bx / 8 : bx;
    const int gw = vcu * NWAVES + wave, NGW = G * NWAVES;
    unsigned char* ws = args.ws;
    const float* x = args.in[0]; const float* ln_pre_mix = args.in[1]; const float* w_in = args.in[2]; const float* w_pool = args.in[3]; const float* pool_scale = args.in[4];
    const float* w_out = args.in[5]; const float* ln_post_mix = args.in[6]; const float* ln_pre_ffn = args.in[7]; const float* w_gate = args.in[8]; const float* w_up = args.in[9];
    const float* w_down = args.in[10]; const float* ln_post_ffn = args.in[11];
    float* out = args.out;
    bf16* Win = (bf16*)(ws + WS_WIN); bf16* Wout = (bf16*)(ws + WS_WOUT); bf16* Wgu = (bf16*)(ws + WS_WGU); bf16* Wdn = (bf16*)(ws + WS_WDN);
    bf16* H = (bf16*)(ws + WS_H); bf16* MIX = (bf16*)(ws + WS_MIX); bf16* UPb = (bf16*)(ws + WS_UP);
    bf16* Qb = (bf16*)(ws + WS_Q); bf16* Kb = (bf16*)(ws + WS_K); bf16* Vb = (bf16*)(ws + WS_V); bf16* MC = (bf16*)(ws + WS_MC); bf16* ACT = (bf16*)(ws + WS_ACT);
    bf16* P16 = (bf16*)(ws + WS_P16); bf16* P4 = (bf16*)(ws + WS_MIX); float* RMS0 = (float*)(ws + WS_RMS0); float* L16 = (float*)(ws + WS_LSE); float* L4 = (float*)(ws + WS_LSE + 2 * MiB);
    volatile LAS unsigned* MISC = (volatile LAS unsigned*)(lds + LDS_BYTES - 64);
    if (tid < 16) MISC[tid] = 0u;
    __syncthreads();
    XcdBarrier bar = xcd_barrier_post((unsigned*)ws, MISC + 8);
    bf16* FB = H;
    const int lo = args.ph_lo, hi = args.ph_hi;
#define IN(k) (lo <= (k) && (k) < hi)
#define SEAM(k) do { if (IN(k) && IN((k) + 1)) xcd_barrier(bar); } while (0)
    if (args.ph_hi > 64) grid.sync();

    if (IN(0)) { p0_prologue(x, ln_pre_mix, w_in, w_out, w_gate, w_up, w_down, ws, lds, gw, NGW, wave, lane, bx * (NWAVES * 64) + tid, G * NWAVES * 64); }
    SEAM(0);
    if (IN(1)) {
        pg8::Gemm g{H, Win, M, NPROJ, DM}; pg8::StaticOrder S; S.init(M, NPROJ, G, bx);
        pg8::EpiProj E{UPb, Qb, Kb, Vb, (const float*)(ws + WS_CS), QSCALE};
        pg8::gemm_phase<pg8::EpiProj, pg8::StaticOrder, true, true>(lds, g, S, E);
    }
    SEAM(1);
    if (IN(2)) { phase2a(UPb, w_pool, pool_scale, Qb, Kb, Vb, MC, P16, L16, P4, L4, lds, gw, NGW, vcu, G, wave, lane); xcd_barrier(bar);
                 phase2b(Qb, Kb, Vb, MC, P16, L16, P4, L4, lds, vcu, G, wave, lane); }
    SEAM(2);
    if (IN(3)) {
        pg8::Gemm g{MC, Wout, M, DM, DM}; pg8::StaticOrder S; S.init(M, DM, G, bx);
        pg8::EpiPlain E{MIX, DM};
        pg8::gemm_phase<pg8::EpiPlain, pg8::StaticOrder, true, true>(lds, g, S, E);
    }
    SEAM(3);
    if (IN(4)) { for (int m = 2 * gw; m < M; m += 2 * NGW) row_mid<2>(RMS0, MIX, ln_pre_mix, ln_post_mix, ln_pre_ffn, H, m, lane); }
    SEAM(4);
    if (IN(5)) {
        pg8::Gemm g{H, Wgu, M, NGU, DM}; pg8::StaticOrder S; S.init(M, NGU, G, bx);
        pg8::EpiSwiGLU E{ACT, DFF};
        pg8::gemm_phase<pg8::EpiSwiGLU, pg8::StaticOrder, true, true>(lds, g, S, E);
    }
    SEAM(5);
    if (IN(6)) {
        pg8::Gemm g{ACT, Wdn, M, DM, DFF}; pg8::StaticOrder S; S.init(M, DM, G, bx);
        pg8::EpiPlain E{FB, DM};
        pg8::gemm_phase<pg8::EpiPlain, pg8::StaticOrder, true, true>(lds, g, S, E);
    }
    SEAM(6);
    if (IN(7)) { for (int m = 4 * gw; m < M; m += 4 * NGW) row_last<4>(MIX, FB, ln_post_ffn, out, m, lane); }
#undef IN
#undef SEAM
}

#ifndef MK_SPLIT
#define MK_SPLIT 0
#endif
extern "C" void kernel_launch(void* const* d_in, const int* in_sizes, int n_in, void* d_out, int out_size, void* d_ws, size_t ws_size, hipStream_t stream) {
    static int grid = 0;
    if (grid == 0) {
        if (n_in != 12 || in_sizes[0] != M * DM || out_size != M * DM || ws_size < WS_END) { fprintf(stderr, "kernel_launch: unexpected shapes (n_in %d, in0 %d, out %d, ws %zu)\n", n_in, n_in > 0 ? in_sizes[0] : -1, out_size, ws_size); grid = -1; return; }
        int dev = 0, cus = 0, per_cu = 0;
        hipGetDevice(&dev); hipDeviceGetAttribute(&cus, hipDeviceAttributeMultiprocessorCount, dev);
        if (hipFuncSetAttribute((const void*)mk_fwd, hipFuncAttributeMaxDynamicSharedMemorySize, LDS_BYTES) != hipSuccess) { fprintf(stderr, "kernel_launch: hipFuncSetAttribute failed\n"); grid = -1; return; }
        if (hipOccupancyMaxActiveBlocksPerMultiprocessor(&per_cu, (const void*)mk_fwd, NWAVES * 64, LDS_BYTES) != hipSuccess || per_cu < 1) { fprintf(stderr, "kernel_launch: occupancy query says %d\n", per_cu); per_cu = 1; }
        (void)hipGetLastError();
        grid = cus * 1;
        fprintf(stderr, "kernel_launch: cus %d per_cu %d grid %d\n", cus, per_cu, grid);
    }
    if (grid < 0) return;
    if (hipMemsetAsync(d_ws, 0, 65536, stream) != hipSuccess) { fprintf(stderr, "kernel_launch: hipMemsetAsync failed\n"); return; }
    Args a{};
    for (int i = 0; i < 12; ++i) a.in[i] = (const float*)d_in[i];
    a.out = (float*)d_out; a.ws = (unsigned char*)d_ws;
#if MK_SPLIT
    for (int p = 0; p < 8; ++p) { a.ph_lo = p; a.ph_hi = p + 1; void* kargs[] = {&a};
        hipError_t e = hipLaunchCooperativeKernel((const void*)mk_fwd, dim3(grid), dim3(NWAVES * 64), kargs, LDS_BYTES, stream);
        if (e != hipSuccess) { fprintf(stderr, "cooperative launch failed: %s\n", hipGetErrorString(e)); break; } }
#else
    a.ph_lo = 0; a.ph_hi = 8; void* kargs[] = {&a};
    hipError_t e = hipLaunchCooperativeKernel((const void*)mk_fwd, dim3(grid), dim3(NWAVES * 64), kargs, LDS_BYTES, stream);
    if (e != hipSuccess) fprintf(stderr, "cooperative launch failed: %s (grid %d)\n", hipGetErrorString(e), grid);
#endif
}
```
